# Optimizing an MI355X kernel written in HIP

```python
import numpy as np
import jax
import jax.numpy as jnp
from jax import lax

D_MODEL = 1024
BATCH = 16
SEQ = 2048
DEPTH = 4

N_MIXERS = 3
HEAD_DIM = 128
ROPE_DIM = HEAD_DIM // 4
ROPE_THETA = 500000.0
NORM_EPS = 1e-6
BLK = 128

A_GROUPS = ((128, 1), (512, 4), (2048, 16))
A_HEADS = D_MODEL // HEAD_DIM
A_WIDTH = A_HEADS * HEAD_DIM
A_IN = 3 * len(A_GROUPS) * A_WIDTH + A_WIDTH

B_HEADS = D_MODEL // HEAD_DIM
B_KV = 2
B_REP = B_HEADS // B_KV
B_WIDTH = B_HEADS * HEAD_DIM
B_KVW = B_KV * HEAD_DIM
CMP_LEN = 32
CMP_STRIDE = 16
CMP_HIDDEN = HEAD_DIM
SEL_LEN = 64
N_SELECT = 16
WIN = 512
SEL_CHUNK = 16
FORCE_SCORE = 1000.0
B_IN = B_WIDTH + 6 * B_KVW + B_WIDTH + 3 * B_HEADS

C_WIDTH = D_MODEL * 5 // 4
C_BLOCKS = 10
C_BLOCK_DIM = C_WIDTH // C_BLOCKS
CONV_W = 4
LRU_C = 8.0

N_A = (DEPTH + 2) // 3
N_B = (DEPTH + 1) // 3
N_C = DEPTH // 3

kernel_name = "hybrid_dilated_nsa_rglru"


def rmsnorm(x, g):
    xf = x.astype(jnp.float32)
    y = xf * lax.rsqrt(jnp.mean(xf * xf, axis=-1, keepdims=True) + NORM_EPS)
    return (y * g.astype(jnp.float32)).astype(x.dtype)


def rope(x):
    S = x.shape[1]
    half = ROPE_DIM // 2
    inv_freq = ROPE_THETA ** (-2.0 * jnp.arange(half, dtype=jnp.float32) / ROPE_DIM)
    ang = jnp.arange(S, dtype=jnp.float32)[:, None] * inv_freq[None, :]
    cos = jnp.cos(ang)[None, :, None, :]
    sin = jnp.sin(ang)[None, :, None, :]
    xf = x.astype(jnp.float32)
    x1 = xf[..., :half]
    x2 = xf[..., half:ROPE_DIM]
    out = jnp.concatenate([x1 * cos - x2 * sin, x2 * cos + x1 * sin, xf[..., ROPE_DIM:]], axis=-1)
    return out.astype(x.dtype)


def masked_softmax(s, mask):
    s = jnp.where(mask, s, -jnp.inf)
    m = jnp.max(s, axis=-1, keepdims=True)
    m = jnp.where(jnp.isfinite(m), m, 0.0)
    e = jnp.exp(s - m)
    den = jnp.sum(e, axis=-1, keepdims=True)
    p = e / jnp.maximum(den, 1e-30)
    lse = (m + jnp.log(den))[..., 0]
    return p, lse


def banded_attention(q, k, v, max_dist):
    B_, L, G, R, Dh = q.shape
    n_prev = -(-max_dist // BLK)
    nb = -(-L // BLK)
    pad = nb * BLK - L
    W = (n_prev + 1) * BLK
    qp = jnp.pad(q, ((0, 0), (0, pad), (0, 0), (0, 0), (0, 0)))
    kp = jnp.pad(k, ((0, 0), (n_prev * BLK, pad), (0, 0), (0, 0)))
    vp = jnp.pad(v, ((0, 0), (n_prev * BLK, pad), (0, 0), (0, 0)))
    qb = qp.reshape(B_, nb, BLK, G, R, Dh)
    kb = kp.reshape(B_, nb + n_prev, BLK, G, Dh)
    vb = vp.reshape(B_, nb + n_prev, BLK, G, Dh)
    kw = jnp.concatenate([kb[:, j:j + nb] for j in range(n_prev + 1)], axis=2)
    vw = jnp.concatenate([vb[:, j:j + nb] for j in range(n_prev + 1)], axis=2)
    s = jnp.einsum('bnqgrd,bnkgd->bngrqk', qb, kw).astype(jnp.float32) * (Dh ** -0.5)
    qpos = jnp.arange(nb)[:, None] * BLK + jnp.arange(BLK)[None, :]
    kpos = jnp.arange(nb)[:, None] * BLK + jnp.arange(W)[None, :] - n_prev * BLK
    dist = qpos[:, :, None] - kpos[:, None, :]
    mask = (dist >= 0) & (dist <= max_dist) & (kpos[:, None, :] >= 0)
    p, lse = masked_softmax(s, mask[None, :, None, None, :, :])
    o = jnp.einsum('bngrqk,bnkgd->bnqgrd', p.astype(vw.dtype), vw)
    o = o.reshape(B_, nb * BLK, G, R, Dh)[:, :L]
    lse = jnp.transpose(lse, (0, 1, 4, 2, 3)).reshape(B_, nb * BLK, G, R)[:, :L]
    return o, lse


def dilate(t, d):
    B_, S = t.shape[:2]
    t = t.reshape(B_, S // d, d, *t.shape[2:])
    t = jnp.moveaxis(t, 2, 1)
    return t.reshape(B_ * d, S // d, *t.shape[3:])


def undilate(t, d, B_):
    L = t.shape[1]
    t = t.reshape(B_, d, L, *t.shape[2:])
    t = jnp.moveaxis(t, 1, 2)
    return t.reshape(B_, L * d, *t.shape[3:])


def mixer_a(xn, w_in, w_out):
    B_, S, _ = xn.shape
    n_g = len(A_GROUPS)
    u = xn @ w_in
    qkv = u[..., :3 * n_g * A_WIDTH].reshape(B_, S, n_g, 3, A_HEADS, HEAD_DIM)
    z = u[..., 3 * n_g * A_WIDTH:]
    outs, lses = [], []
    for g, (win, dil) in enumerate(A_GROUPS):
        q = dilate(rope(qkv[:, :, g, 0]), dil)[:, :, :, None, :]
        k = dilate(rope(qkv[:, :, g, 1]), dil)
        v = dilate(qkv[:, :, g, 2], dil)
        o, lse = banded_attention(q, k, v, win // dil)
        outs.append(undilate(o[:, :, :, 0], dil, B_))
        lses.append(undilate(lse[:, :, :, 0], dil, B_))
    alpha = jax.nn.softmax(jnp.stack(lses), axis=0)
    o = jnp.sum(alpha[..., None] * jnp.stack(outs).astype(jnp.float32), axis=0)
    y = o.reshape(B_, S, A_WIDTH).astype(xn.dtype) * jax.nn.silu(z)
    return y @ w_out


def compress(k, pe, w1, w2):
    B_, S, G, Dh = k.shape
    ch = k.reshape(B_, S // CMP_STRIDE, CMP_STRIDE, G, Dh)
    blocks = jnp.concatenate([ch[:, :-1], ch[:, 1:]], axis=2)
    h = jax.nn.silu(jnp.einsum('bjpgd,pde->bjge', blocks + pe[:, None, :], w1))
    return jnp.einsum('bjge,ef->bjgf', h, w2)


def block_cover(S):
    n_cmp = S // CMP_STRIDE - 1
    n_slc = S // SEL_LEN
    j = np.arange(n_cmp)[:, None]
    s = np.arange(n_slc)[None, :]
    cover = (j * CMP_STRIDE < (s + 1) * SEL_LEN) & (j * CMP_STRIDE + CMP_LEN > s * SEL_LEN)
    return jnp.asarray(cover.astype(np.float32))


def selected_attention(q, k, v, idx, valid):
    B_, S, G, R, Dh = q.shape
    n_slc = S // SEL_LEN
    K = idx.shape[-1]
    nc = S // SEL_CHUNK
    kb = jnp.transpose(k.reshape(B_, n_slc, SEL_LEN, G, Dh), (0, 3, 1, 2, 4))
    vb = jnp.transpose(v.reshape(B_, n_slc, SEL_LEN, G, Dh), (0, 3, 1, 2, 4))
    qc = jnp.transpose(q.reshape(B_, nc, SEL_CHUNK, G, R, Dh), (1, 0, 3, 4, 2, 5))
    ic = jnp.transpose(idx.reshape(B_, G, nc, SEL_CHUNK, K), (2, 0, 1, 3, 4))
    vc = jnp.transpose(valid.reshape(B_, G, nc, SEL_CHUNK, K), (2, 0, 1, 3, 4))
    tc = jnp.arange(S).reshape(nc, SEL_CHUNK)
    bi = jnp.arange(B_)[:, None, None, None]
    gi = jnp.arange(G)[None, :, None, None]

    def one_chunk(args):
        qx, ix, vx, tx = args
        gk = kb[bi, gi, ix]
        gv = vb[bi, gi, ix]
        s = jnp.einsum('bgrcd,bgckld->bgrckl', qx, gk).astype(jnp.float32) * (Dh ** -0.5)
        tok = ix[..., None] * SEL_LEN + jnp.arange(SEL_LEN)
        mask = (tok <= tx[None, None, :, None, None]) & vx[..., None]
        s = s.reshape(B_, G, R, SEL_CHUNK, K * SEL_LEN)
        mask = mask[:, :, None].reshape(B_, G, 1, SEL_CHUNK, K * SEL_LEN)
        p, _ = masked_softmax(s, mask)
        return jnp.einsum('bgrcn,bgcnd->bgrcd', p.astype(gv.dtype),
                          gv.reshape(B_, G, SEL_CHUNK, K * SEL_LEN, Dh))

    o = lax.map(one_chunk, (qc, ic, vc, tc))
    return jnp.transpose(o, (1, 0, 4, 2, 3, 5)).reshape(B_, S, G, R, Dh)


def mixer_b(xn, w_in, gate_b, pe_k, w1_k, w2_k, pe_v, w1_v, w2_v, w_out):
    B_, S, _ = xn.shape
    u = xn @ w_in
    o0 = B_WIDTH
    o1 = o0 + 6 * B_KVW
    o2 = o1 + B_WIDTH
    q = rope(u[..., :o0].reshape(B_, S, B_HEADS, HEAD_DIM)).reshape(B_, S, B_KV, B_REP, HEAD_DIM)
    kv = u[..., o0:o1].reshape(B_, S, 6, B_KV, HEAD_DIM)
    k_cmp, v_cmp = rope(kv[:, :, 0]), kv[:, :, 1]
    k_sel, v_sel = rope(kv[:, :, 2]), kv[:, :, 3]
    k_win, v_win = rope(kv[:, :, 4]), kv[:, :, 5]
    z = u[..., o1:o2]
    gates = jax.nn.sigmoid((u[..., o2:] + gate_b).astype(jnp.float32)).reshape(B_, S, B_KV, B_REP, 3)

    kc = compress(k_cmp, pe_k, w1_k, w2_k)
    vc = compress(v_cmp, pe_v, w1_v, w2_v)
    n_cmp = kc.shape[1]
    t = jnp.arange(S)
    blk_end = jnp.arange(n_cmp) * CMP_STRIDE + CMP_LEN - 1
    s = jnp.einsum('bsgrd,bjgd->bgrsj', q, kc).astype(jnp.float32) * (HEAD_DIM ** -0.5)
    p_cmp, _ = masked_softmax(s, blk_end[None, :] <= t[:, None])
    o_cmp = jnp.einsum('bgrsj,bjgd->bsgrd', p_cmp.astype(vc.dtype), vc)

    n_slc = S // SEL_LEN
    p_slc = jnp.einsum('bgrsj,jn->bgsn', p_cmp, block_cover(S))
    blk = jnp.arange(n_slc)[None, :]
    cur = (t // SEL_LEN)[:, None]
    forced = (blk == 0) | (blk == cur) | (blk == cur - 1)
    score = jnp.where(blk <= cur, jnp.where(forced, FORCE_SCORE, p_slc), -jnp.inf)
    vals, idx = lax.top_k(score, min(N_SELECT, n_slc))
    o_sel = selected_attention(q, k_sel, v_sel, idx, jnp.isfinite(vals))

    o_win, _ = banded_attention(q, k_win, v_win, WIN - 1)

    o = gates[..., 0:1] * o_cmp + gates[..., 1:2] * o_sel + gates[..., 2:3] * o_win
    y = o.reshape(B_, S, B_WIDTH).astype(xn.dtype) * jax.nn.silu(z)
    return y @ w_out


def mixer_c(xn, w_in, conv_w, conv_b, wa, ba, wx, bx, lam, w_out):
    B_, S, _ = xn.shape
    u = xn @ w_in
    xb = u[..., :C_WIDTH]
    z = u[..., C_WIDTH:]
    xc = lax.conv_general_dilated(xb, conv_w[:, None, :], window_strides=(1,),
                                  padding=[(CONV_W - 1, 0)],
                                  dimension_numbers=('NWC', 'WIO', 'NWC'),
                                  feature_group_count=C_WIDTH) + conv_b
    xr = xc.reshape(B_, S, C_BLOCKS, C_BLOCK_DIM)
    r = jax.nn.sigmoid((jnp.einsum('bsnc,ncd->bsnd', xr, wa).reshape(B_, S, C_WIDTH) + ba).astype(jnp.float32))
    i = jax.nn.sigmoid((jnp.einsum('bsnc,ncd->bsnd', xr, wx).reshape(B_, S, C_WIDTH) + bx).astype(jnp.float32))
    log_a = -LRU_C * r * jax.nn.softplus(-lam.astype(jnp.float32))
    a = jnp.exp(log_a)
    b = jnp.sqrt(-jnp.expm1(2.0 * log_a)) * i * xc.astype(jnp.float32)

    def combine(left, right):
        a1, b1 = left
        a2, b2 = right
        return a1 * a2, a2 * b1 + b2

    _, h = lax.associative_scan(combine, (a, b), axis=1)
    y = h.astype(xn.dtype) * jax.nn.silu(z)
    return y @ w_out


def _normal(key, shape, scale):
    return scale * jax.random.normal(key, shape, dtype=jnp.float32)


def setup_inputs(seed: int = 0) -> dict:
    key = jax.random.key(seed)
    ks = jax.random.split(key, 24)
    hd = HEAD_DIM
    a0 = jax.random.uniform(ks[22], (N_C, C_WIDTH), dtype=jnp.float32, minval=0.9, maxval=0.999)
    p = a0 ** (1.0 / LRU_C)
    return {
        'x': _normal(ks[0], (BATCH, SEQ, D_MODEL), 1.0),
        'norm_g': 1.0 + _normal(ks[1], (DEPTH, D_MODEL), 0.1),
        'final_g': 1.0 + _normal(ks[2], (D_MODEL,), 0.1),
        'a_w_in': _normal(ks[3], (N_A, D_MODEL, A_IN), D_MODEL ** -0.5),
        'a_w_out': _normal(ks[4], (N_A, A_WIDTH, D_MODEL), A_WIDTH ** -0.5),
        'b_w_in': _normal(ks[5], (N_B, D_MODEL, B_IN), D_MODEL ** -0.5),
        'b_gate_b': _normal(ks[6], (N_B, 3 * B_HEADS), 0.1),
        'b_pe_k': _normal(ks[7], (N_B, CMP_LEN, hd), 0.5),
        'b_w1_k': _normal(ks[8], (N_B, CMP_LEN, hd, CMP_HIDDEN), (CMP_LEN * hd) ** -0.5),
        'b_w2_k': _normal(ks[9], (N_B, CMP_HIDDEN, hd), CMP_HIDDEN ** -0.5),
        'b_pe_v': _normal(ks[10], (N_B, CMP_LEN, hd), 0.5),
        'b_w1_v': _normal(ks[11], (N_B, CMP_LEN, hd, CMP_HIDDEN), (CMP_LEN * hd) ** -0.5),
        'b_w2_v': _normal(ks[12], (N_B, CMP_HIDDEN, hd), CMP_HIDDEN ** -0.5),
        'b_w_out': _normal(ks[13], (N_B, B_WIDTH, D_MODEL), B_WIDTH ** -0.5),
        'c_w_in': _normal(ks[14], (N_C, D_MODEL, 2 * C_WIDTH), D_MODEL ** -0.5),
        'c_conv_w': _normal(ks[15], (N_C, CONV_W, C_WIDTH), CONV_W ** -0.5),
        'c_conv_b': _normal(ks[16], (N_C, C_WIDTH), 0.02),
        'c_wa': _normal(ks[17], (N_C, C_BLOCKS, C_BLOCK_DIM, C_BLOCK_DIM), C_BLOCK_DIM ** -0.5),
        'c_ba': _normal(ks[18], (N_C, C_WIDTH), 0.1),
        'c_wx': _normal(ks[19], (N_C, C_BLOCKS, C_BLOCK_DIM, C_BLOCK_DIM), C_BLOCK_DIM ** -0.5),
        'c_bx': _normal(ks[20], (N_C, C_WIDTH), 0.1),
        'c_lambda': jnp.log(p) - jnp.log1p(-p),
        'c_w_out': _normal(ks[21], (N_C, C_WIDTH, D_MODEL), C_WIDTH ** -0.5),
    }


def reference(x, norm_g, final_g, a_w_in, a_w_out, b_w_in, b_gate_b, b_pe_k, b_w1_k, b_w2_k,
              b_pe_v, b_w1_v, b_w2_v, b_w_out, c_w_in, c_conv_w, c_conv_b, c_wa, c_ba,
              c_wx, c_bx, c_lambda, c_w_out):
    for i in range(DEPTH):
        kind = i % N_MIXERS
        j = i // N_MIXERS
        h = rmsnorm(x, norm_g[i])
        if kind == 0:
            y = mixer_a(h, a_w_in[j], a_w_out[j])
        elif kind == 1:
            y = mixer_b(h, b_w_in[j], b_gate_b[j], b_pe_k[j], b_w1_k[j], b_w2_k[j],
                        b_pe_v[j], b_w1_v[j], b_w2_v[j], b_w_out[j])
        else:
            y = mixer_c(h, c_w_in[j], c_conv_w[j], c_conv_b[j], c_wa[j], c_ba[j],
                        c_wx[j], c_bx[j], c_lambda[j], c_w_out[j])
        x = x + y
    return rmsnorm(x, final_g)
```

```cpp
#include <hip/hip_runtime.h>
#include <hip/hip_cooperative_groups.h>
#include <cstdio>
namespace cg = cooperative_groups;

typedef unsigned short bf16_t;
typedef short bf16x8 __attribute__((ext_vector_type(8)));
typedef short s16x4 __attribute__((ext_vector_type(4)));
typedef float f32x2 __attribute__((ext_vector_type(2)));
typedef float f32x4 __attribute__((ext_vector_type(4)));
typedef float f32x16 __attribute__((ext_vector_type(16)));
typedef unsigned u32x2 __attribute__((ext_vector_type(2)));
typedef unsigned u32x4 __attribute__((ext_vector_type(4)));
typedef __bf16 bf2_t __attribute__((ext_vector_type(2)));
#define LAS __attribute__((address_space(3)))
#define DI __device__ __forceinline__

DI unsigned pk2(float lo, float hi) { f32x2 v = {lo, hi}; bf2_t b = __builtin_convertvector(v, bf2_t); return __builtin_bit_cast(unsigned, b); }
DI float bflo(unsigned u) { return __uint_as_float(u << 16); }
DI float bfhi(unsigned u) { return __uint_as_float(u & 0xffff0000u); }
DI float bf2f(bf16_t b) { return __uint_as_float(((unsigned)b) << 16); }
DI float sigm(float x) { return 1.f / (1.f + __expf(-x)); }
DI float silu(float x) { return x / (1.f + __expf(-x)); }
DI void st16_wt(void* p, u32x4 v) { asm volatile("global_store_dwordx4 %0, %1, off sc1\n\ts_nop 1" :: "v"(p), "v"(v) : "memory"); }
DI void st8_wt(void* p, u32x2 v) { asm volatile("global_store_dwordx2 %0, %1, off sc1\n\ts_nop 1" :: "v"(p), "v"(v) : "memory"); }
DI void st16f_wt(float* p, f32x4 v) { asm volatile("global_store_dwordx4 %0, %1, off sc1\n\ts_nop 1" :: "v"(p), "v"(v) : "memory"); }
DI int BID() { int t = blockIdx.x; asm volatile("" : "+s"(t)); return t; }
DI int NBLK() { int t = gridDim.x; asm volatile("" : "+s"(t)); return t; }
DI int TID() { int t = threadIdx.x; asm volatile("" : "+v"(t)); return t; }

constexpr size_t XCD_BAR_BYTES = 3456 * 4;
constexpr size_t OFF_WAIN = 0;
constexpr size_t OFF_WAOUT = OFF_WAIN + 2ull * 10240 * 1024 * 2;
constexpr size_t OFF_WBIN = OFF_WAOUT + 2ull * 1024 * 1024 * 2;
constexpr size_t OFF_WBOUT = OFF_WBIN + 3840ull * 1024 * 2;
constexpr size_t OFF_WCIN = OFF_WBOUT + 1024ull * 1024 * 2;
constexpr size_t OFF_WCOUT = OFF_WCIN + 2560ull * 1024 * 2;
constexpr size_t OFF_WCMP1 = OFF_WCOUT + 1024ull * 1280 * 2;
constexpr size_t OFF_WCMP2 = OFF_WCMP1 + 256ull * 4096 * 2;
constexpr size_t OFF_WGATE = OFF_WCMP2 + 256ull * 256 * 2;
constexpr size_t OFF_ROPE = OFF_WGATE + 10ull * 256 * 128 * 2;
constexpr size_t OFF_BIAS1 = OFF_ROPE + 2048ull * 32 * 4;
constexpr size_t OFF_SP8 = OFF_BIAS1 + 1024;
constexpr size_t OFF_XB = OFF_BIAS1 + 8192;
constexpr size_t OFF_R = OFF_XB + 32768ull * 1024 * 2;
constexpr size_t OFF_UA = OFF_R;
constexpr size_t OFF_ZA = OFF_UA + 8192ull * 9216 * 2;
constexpr size_t OFF_OG = OFF_ZA + 32768ull * 1024 * 2;
constexpr size_t OFF_LSE = OFF_OG + 3ull * 8192 * 1024 * 2;
constexpr size_t OFF_UB = OFF_R;
constexpr size_t OFF_UBZ = OFF_UB + 16ull * 32768 * 128 * 2;
constexpr size_t OFF_KVC = OFF_UBZ + 32768ull * 1056 * 2;
constexpr size_t OFF_HB = OFF_KVC + 2ull * 16 * 2 * 2048 * 128 * 2 + 8192;
constexpr size_t OFF_KC = OFF_HB + 8192ull * 256 * 2;
constexpr size_t OFF_VC = OFF_KC + 4096ull * 128 * 2;
constexpr size_t OFF_SELM = OFF_VC + 4096ull * 128 * 2;
constexpr size_t OFF_AB = OFF_XB;
constexpr size_t OFF_XRAW = OFF_AB + 32768ull * 1280 * 4;
constexpr size_t OFF_ZC = OFF_XRAW + 32768ull * 1280 * 2;
constexpr size_t OFF_XC = OFF_ZC + 32768ull * 1280 * 2;
constexpr size_t OFF_CARRY = OFF_XC + 32768ull * 1280 * 2;
constexpr size_t OFF_BPART = OFF_CARRY + 16ull * 32 * 1280 * 8;
constexpr size_t OFF_BAR = OFF_BPART + 1024ull * 256 * 4;
constexpr size_t WS_NEED = OFF_BAR + XCD_BAR_BYTES + 256;

struct Params {
    const float *x, *norm_g, *final_g, *a_w_in, *a_w_out, *b_w_in, *b_gate_b, *b_pe_k, *b_w1_k, *b_w2_k, *b_pe_v, *b_w1_v, *b_w2_v, *b_w_out,
        *c_w_in, *c_conv_w, *c_conv_b, *c_wa, *c_ba, *c_wx, *c_bx, *c_lambda, *c_w_out;
    float* out; unsigned char* ws;
    int ph_lo, ph_hi, coop, pad;
};
typedef const __attribute__((address_space(4))) Params& PR;

namespace pg8 {
constexpr int BM = 256, BK = 64, HALF = 128, HTB = HALF * BK * 2, STAGE_BYTES = 8 * HTB, NXCD = 8, WGM = 8;
DI int lds_byte(int r, int c) { const int st = (r >> 4) * 2 + (c >> 5), rr = r & 15, cc = c & 31, ob = rr * 64 + cc * 2; return st * 1024 + (ob ^ (((ob >> 9) & 1) << 5)); }
DI void stage_rc(int b, int& R, int& C) { const int st = b / 1024, sb = b % 1024, swz = sb ^ (((sb >> 9) & 1) << 5); R = (st >> 1) * 16 + swz / 64; C = (st & 1) * 32 + (swz % 64) / 2; }
DI int perm32(int rho) { const int n = rho >> 4, i = rho & 15; return 8 * (i >> 2) + 4 * n + (i & 3); }
struct Unit { int pm, pn; };
struct Gemm { const bf16_t* A; const bf16_t* Bt; int M, N, K, lda; int apn; };
struct StaticOrder {
    int nM, nN, nwg, G, c;
    DI void init(int M, int N, int G_, int c_) { nM = M / BM; nN = N / BM; nwg = nM * nN; G = G_; c = c_; }
    DI bool next(int i, Unit& u) const {
        const long L = (long)i * G + c; if (L >= nwg) return false;
        int wgid = (int)L; { const int q = nwg / NXCD, r = nwg % NXCD, xcd = wgid % NXCD, off = wgid / NXCD; wgid = (xcd < r ? xcd * (q + 1) : r * (q + 1) + (xcd - r) * q) + off; }
        const int nig = WGM * nN, gid = wgid / nig, fm = gid * WGM, gsz = (nM - fm) < WGM ? (nM - fm) : WGM;
        u.pm = fm + ((wgid % nig) % gsz); u.pn = (wgid % nig) / gsz; return true;
    }
};

template <class Epi>
DI void gemm_phase(LAS unsigned char* lds, const Gemm g, const StaticOrder& S, const Epi& E) {
    const int tid = TID(), wid = __builtin_amdgcn_readfirstlane(tid >> 6), lane = tid & 63, wr = wid >> 2, wc = wid & 3, fr = lane & 15, fq = lane >> 4;
    const int K = g.K, nt = K / BK;
    unsigned voffA[2], voffB[2];
#pragma unroll
    for (int i = 0; i < 2; ++i) { int R, C; stage_rc(tid * 16 + i * 8192, R, C); const int Rb = Epi::PERM ? ((R & ~31) + perm32(R & 31)) : R;
        voffA[i] = (unsigned)(R * g.lda + C) * 2u; voffB[i] = (unsigned)(Rb * K + C) * 2u; }
    const size_t kstep = (size_t)(BK * 2);
    const size_t hstepA = (size_t)HALF * g.lda * 2, hstepB = (size_t)HALF * K * 2;
    const size_t tstepA = 2 * hstepA, tstepB = 2 * hstepB;
    const unsigned ldsw = (unsigned)wid * 1024u;
    const int aoff = lds_byte(wr * 64 + fr, fq * 8), boff = lds_byte(wc * 32 + fr, fq * 8);
#define PG8_SA(b, h) (((b) * 2 + (h)) * HTB)
#define PG8_SB(b, h) ((4 + (b) * 2 + (h)) * HTB)
#define PG8_STAGE(bufoff, gbase, voff) do { _Pragma("unroll") for (int _i = 0; _i < 2; ++_i) { unsigned _vo = (voff)[_i]; asm volatile("" : "+v"(_vo)); \
        __builtin_amdgcn_global_load_lds((const unsigned*)((const char*)(gbase) + _vo), (LAS unsigned*)(lds + (bufoff) + ldsw + _i * 8192), 16, 0, 0); } } while (0)
#define PG8_LDA(dst, b, h) do { _Pragma("unroll") for (int m = 0; m < 4; ++m) _Pragma("unroll") for (int k = 0; k < 2; ++k) dst[m][k] = *(const LAS bf16x8*)(lds + PG8_SA(b, h) + aoff + m * 2048 + k * 1024); } while (0)
#define PG8_LDB(dst, b, h) do { _Pragma("unroll") for (int n = 0; n < 2; ++n) _Pragma("unroll") for (int k = 0; k < 2; ++k) dst[n][k] = *(const LAS bf16x8*)(lds + PG8_SB(b, h) + boff + n * 2048 + k * 1024); } while (0)
#define PG8_MMA(ai, bj, At, Bt) do { __builtin_amdgcn_s_setprio(1); _Pragma("unroll") for (int m = 0; m < 4; ++m) _Pragma("unroll") for (int n = 0; n < 2; ++n) _Pragma("unroll") for (int k = 0; k < 2; ++k) \
        acc[ai][bj][m][n] = __builtin_amdgcn_mfma_f32_16x16x32_bf16(Bt[n][k], At[m][k], acc[ai][bj][m][n], 0, 0, 0); __builtin_amdgcn_s_setprio(0); } while (0)
#define PG8_WAIT_V(n) asm volatile("s_waitcnt vmcnt(" #n ")" ::: "memory")
#define PG8_WAIT_L(n) asm volatile("s_waitcnt lgkmcnt(" #n ")" ::: "memory")
#define PG8_BAR __builtin_amdgcn_s_barrier()
#define PG8_SCHED __builtin_amdgcn_sched_barrier(0)
    Unit cur, nxt; int ui = 0;
    if (!S.next(0, cur)) return;
    f32x4 acc[2][2][4][2];
#pragma unroll
    for (int a = 0; a < 2; ++a)
#pragma unroll
        for (int b = 0; b < 2; ++b)
#pragma unroll
            for (int m = 0; m < 4; ++m)
#pragma unroll
                for (int n = 0; n < 2; ++n) acc[a][b][m][n] = (f32x4){0.f, 0.f, 0.f, 0.f};
    bf16x8 At[4][2], B0[2][2], B1[2][2];
    const char* cA = (const char*)g.A + (size_t)cur.pm * tstepA + (size_t)cur.pn * g.apn; const char* cB = (const char*)g.Bt + (size_t)cur.pn * tstepB;
    PG8_STAGE(PG8_SB(0, 0), cB, voffB); PG8_STAGE(PG8_SA(0, 0), cA, voffA); PG8_STAGE(PG8_SB(0, 1), cB + hstepB, voffB); PG8_STAGE(PG8_SA(0, 1), cA + hstepA, voffA);
    if (wr == 1) PG8_BAR;
    PG8_WAIT_V(4); PG8_BAR;
    PG8_STAGE(PG8_SB(1, 0), cB + kstep, voffB); PG8_STAGE(PG8_SA(1, 0), cA + kstep, voffA); PG8_STAGE(PG8_SB(1, 1), cB + hstepB + kstep, voffB);
    PG8_WAIT_V(6); PG8_BAR;
    for (;;) {
        const bool has_next = S.next(ui + 1, nxt);
        const char* nA = has_next ? (const char*)g.A + (size_t)nxt.pm * tstepA + (size_t)nxt.pn * g.apn : cA; const char* nB = has_next ? (const char*)g.Bt + (size_t)nxt.pn * tstepB : cB;
        for (int t = 0; t < nt; t += 2) {
            const bool last = (t == nt - 2);
            const char* a1 = cA + (size_t)(t + 1) * kstep;
            const char* a2 = last ? nA : cA + (size_t)(t + 2) * kstep; const char* b2 = last ? nB : cB + (size_t)(t + 2) * kstep;
            const char* a3 = a2 + kstep; const char* b3 = b2 + kstep;
            PG8_LDB(B0, 0, 0); PG8_SCHED; PG8_LDA(At, 0, 0); PG8_STAGE(PG8_SA(1, 1), a1 + hstepA, voffA);
            PG8_WAIT_L(8); PG8_BAR; PG8_WAIT_L(0); PG8_MMA(0, 0, At, B0); PG8_BAR; PG8_SCHED;
            PG8_LDB(B1, 0, 1); PG8_STAGE(PG8_SB(0, 0), b2, voffB);
            PG8_BAR; PG8_WAIT_L(0); PG8_MMA(0, 1, At, B1); PG8_BAR;
            PG8_LDA(At, 0, 1); PG8_STAGE(PG8_SA(0, 0), a2, voffA);
            PG8_BAR; PG8_WAIT_L(0); PG8_MMA(1, 0, At, B0); PG8_BAR; PG8_SCHED;
            PG8_STAGE(PG8_SB(0, 1), b2 + hstepB, voffB);
            PG8_WAIT_V(6); PG8_BAR; PG8_MMA(1, 1, At, B1); PG8_BAR;
            PG8_LDB(B0, 1, 0); PG8_SCHED; PG8_LDA(At, 1, 0); PG8_STAGE(PG8_SA(0, 1), a2 + hstepA, voffA);
            PG8_WAIT_L(8); PG8_BAR; PG8_WAIT_L(0); PG8_MMA(0, 0, At, B0); PG8_BAR; PG8_SCHED;
            PG8_LDB(B1, 1, 1); PG8_STAGE(PG8_SB(1, 0), b3, voffB);
            PG8_BAR; PG8_WAIT_L(0); PG8_MMA(0, 1, At, B1); PG8_BAR;
            PG8_LDA(At, 1, 1); PG8_STAGE(PG8_SA(1, 0), a3, voffA);
            PG8_BAR; PG8_WAIT_L(0); PG8_MMA(1, 0, At, B0); PG8_BAR; PG8_SCHED;
            PG8_STAGE(PG8_SB(1, 1), b3 + hstepB, voffB);
            PG8_WAIT_V(6); PG8_BAR; PG8_MMA(1, 1, At, B1); PG8_BAR;
        }
        E(acc, cur, wr, wc, fr, fq);
        if (!has_next) break;
#pragma unroll
        for (int a = 0; a < 2; ++a)
#pragma unroll
            for (int b = 0; b < 2; ++b)
#pragma unroll
                for (int m = 0; m < 4; ++m)
#pragma unroll
                    for (int n = 0; n < 2; ++n) acc[a][b][m][n] = (f32x4){0.f, 0.f, 0.f, 0.f};
        cur = nxt; cA = nA; cB = nB; ++ui;
    }
    PG8_WAIT_V(0);
    if (wr == 0) PG8_BAR;
    PG8_BAR;
#undef PG8_SA
#undef PG8_SB
#undef PG8_STAGE
#undef PG8_LDA
#undef PG8_LDB
#undef PG8_MMA
#undef PG8_WAIT_V
#undef PG8_WAIT_L
#undef PG8_BAR
#undef PG8_SCHED
}
}
using pg8::Unit;

template <int KIND> struct EpiU {
    static constexpr bool PERM = true;
    bf16_t* U; bf16_t* Z; bf16_t* Z2; const float* rope;
    DI void operator()(const f32x4 (&acc)[2][2][4][2], const Unit& u, int wr, int wc, int fr, int fq) const {
        const int rowb = u.pm * 256 + wr * 64 + fr;
#pragma unroll
        for (int bj = 0; bj < 2; ++bj) {
            const int hh = 2 * u.pn + bj;
            const int col = u.pn * 256 + bj * 128 + wc * 32 + 8 * fq;
            bool dorope = false, ropep = false, store = true, cmp = false; bf16_t* dst = U; long ld = 0, cofs = 0; int which = 0, gg = 0;
            if (KIND == 0) { ropep = hh < 72 && ((hh % 24) < 16); if (hh < 72) { dst = U + (size_t)hh * 8192 * 128; ld = 128; cofs = col & 127; } else { dst = Z; ld = 1024; cofs = col - 9216; } }
            if (KIND == 1) { dorope = (hh == 8 || hh == 9); ropep = hh < 8 || hh == 12 || hh == 13 || hh == 16 || hh == 17;
                if (hh >= 8 && hh < 12) { cmp = true; which = (hh - 8) >> 1; gg = (hh - 8) & 1; dst = Z; }
                else if (hh < 20) { dst = U + (size_t)(hh < 8 ? hh : hh - 4) * 32768 * 128; ld = 128; cofs = col & 127; }
                else { dst = Z2; ld = 1056; cofs = col - 2560; store = (cofs + 8 <= 1056); } }
            if (KIND == 2) { if (hh < 10) { dst = U; ld = 1280; cofs = col; } else { dst = Z; ld = 1280; cofs = col - 1280; } }
            const bool rp = dorope && (wc == 0);
            const float sg = (fq < 2) ? -1.f : 1.f;
#pragma unroll
            for (int ai = 0; ai < 2; ++ai) {
                f32x4 cq[4], sq[4];
                if (ropep && fq == 0) {
#pragma unroll
                    for (int m = 0; m < 4; ++m) { const float* cs = rope + ((rowb + ai * 128 + m * 16) & 2047) * 32 + 4 * wc; cq[m] = *(const f32x4*)cs; sq[m] = *(const f32x4*)(cs + 16); }
                }
                asm volatile("" ::: "memory");
#pragma unroll
                for (int m = 0; m < 4; ++m) {
                    const int row = rowb + ai * 128 + m * 16;
                    f32x4 v0 = acc[ai][bj][m][0], v1 = acc[ai][bj][m][1];
                    if (ropep) {
                        if (fq == 0) { const f32x4 c = cq[m], s = sq[m];
                            const f32x4 n0 = v0 * c - v1 * s, n1 = v1 * c + v0 * s; v0 = n0; v1 = n1; }
                    } else if (rp) {
                        const float* cs = rope + (row & 2047) * 32 + 8 * (fq & 1);
                        const f32x4 c0 = *(const f32x4*)cs, c1 = *(const f32x4*)(cs + 4), s0 = *(const f32x4*)(cs + 16), s1 = *(const f32x4*)(cs + 20);
                        f32x4 p0, p1;
#pragma unroll
                        for (int e = 0; e < 4; ++e) { p0[e] = __shfl_xor(v0[e], 32); p1[e] = __shfl_xor(v1[e], 32); }
                        v0 = v0 * c0 + sg * (p0 * s0); v1 = v1 * c1 + sg * (p1 * s1);
                    }
                    u32x4 w; w[0] = pk2(v0[0], v0[1]); w[1] = pk2(v0[2], v0[3]); w[2] = pk2(v1[0], v1[1]); w[3] = pk2(v1[2], v1[3]);
                    if (cmp) { const int b = row >> 11, t = row & 2047; *(u32x4*)(dst + ((((size_t)which * 16 + b) * 2 + gg) * 2048 + t) * 128 + (col & 127)) = w; }
                    else if (store) *(u32x4*)(dst + (size_t)row * ld + cofs) = w;
                }
            }
        }
    }
};
struct EpiRes {
    static constexpr bool PERM = false;
    const float* xin; float* xout;
    DI void operator()(const f32x4 (&acc)[2][2][4][2], const Unit& u, int wr, int wc, int fr, int fq) const {
        const int row0 = u.pm * 256 + wr * 64 + fr, col0 = u.pn * 256 + wc * 32 + 4 * fq;
#pragma unroll
        for (int ai = 0; ai < 2; ++ai) {
            f32x4 xr[4][2][2];
#pragma unroll
            for (int m = 0; m < 4; ++m) { const size_t off = (size_t)(row0 + ai * 128 + m * 16) * 1024 + col0;
#pragma unroll
                for (int bj = 0; bj < 2; ++bj)
#pragma unroll
                    for (int n = 0; n < 2; ++n) xr[m][bj][n] = *(const f32x4*)(xin + off + bj * 128 + n * 16); }
            asm volatile("" ::: "memory");
#pragma unroll
            for (int m = 0; m < 4; ++m) { const size_t off = (size_t)(row0 + ai * 128 + m * 16) * 1024 + col0;
#pragma unroll
                for (int bj = 0; bj < 2; ++bj)
#pragma unroll
                    for (int n = 0; n < 2; ++n) *(f32x4*)(xout + off + bj * 128 + n * 16) = xr[m][bj][n] + acc[ai][bj][m][n]; }
            asm volatile("" ::: "memory");
        }
    }
};
struct EpiCmp1 {
    static constexpr bool PERM = true;
    bf16_t* H; const float* bias;
    DI void operator()(const f32x4 (&acc)[2][2][4][2], const Unit& u, int wr, int wc, int fr, int fq) const {
        const int rowb = u.pm * 256 + wr * 64 + fr; const int sel = (u.pm >= 16) ? 1 : 0;
#pragma unroll
        for (int bj = 0; bj < 2; ++bj) {
            const int col = bj * 128 + wc * 32 + 8 * fq;
            const f32x4 b0 = *(const f32x4*)(bias + col), b1 = *(const f32x4*)(bias + col + 4);
#pragma unroll
            for (int ai = 0; ai < 2; ++ai)
#pragma unroll
                for (int m = 0; m < 4; ++m) {
                    const int row = rowb + ai * 128 + m * 16;
                    u32x4 w = {0u, 0u, 0u, 0u};
                    if (bj == sel) { f32x4 v0 = acc[ai][bj][m][0] + b0, v1 = acc[ai][bj][m][1] + b1;
                        w[0] = pk2(silu(v0[0]), silu(v0[1])); w[1] = pk2(silu(v0[2]), silu(v0[3])); w[2] = pk2(silu(v1[0]), silu(v1[1])); w[3] = pk2(silu(v1[2]), silu(v1[3])); }
                    *(u32x4*)(H + (size_t)row * 256 + col) = w;
                }
        }
    }
};
struct EpiCmp2 {
    static constexpr bool PERM = true;
    bf16_t* KC; bf16_t* VC;
    DI void operator()(const f32x4 (&acc)[2][2][4][2], const Unit& u, int wr, int wc, int fr, int fq) const {
        const int rowb = u.pm * 256 + wr * 64 + fr; const bool sel = (u.pm >= 16);
        bf16_t* dst0 = (sel ? VC + (size_t)(rowb - 4096) * 128 : KC + (size_t)rowb * 128) + wc * 32 + 8 * fq;
#pragma unroll
        for (int ai = 0; ai < 2; ++ai)
#pragma unroll
            for (int m = 0; m < 4; ++m) {
                const int row = rowb + ai * 128 + m * 16;
                const f32x4 v0 = sel ? acc[ai][1][m][0] : acc[ai][0][m][0], v1 = sel ? acc[ai][1][m][1] : acc[ai][0][m][1];
                u32x4 w; w[0] = pk2(v0[0], v0[1]); w[1] = pk2(v0[2], v0[3]); w[2] = pk2(v1[0], v1[1]); w[3] = pk2(v1[2], v1[3]);
                if ((row & 127) == 127) w = (u32x4){0u, 0u, 0u, 0u};
                *(u32x4*)(dst0 + (size_t)(ai * 128 + m * 16) * 128) = w;
            }
    }
};
constexpr int KT_P = 272, VT_P = 320, KT_B = 64 * KT_P, VT_B = 64 * VT_P, HB_B = KT_B + VT_B;
constexpr int LDS_WORK = 4 * HB_B;
constexpr int LDS_BYTES = LDS_WORK + 16;
#define MFMA32(a, b, c) __builtin_amdgcn_mfma_f32_32x32x16_bf16((a), (b), (c), 0, 0, 0)
DI s16x4 trrd(LAS const unsigned char* p) { return __builtin_amdgcn_ds_read_tr16_b64_v4i16((LAS s16x4*)p); }
DI bf16x8 pack8(const f32x16& x, int s) {
    u32x4 p; p[0] = pk2(x[8 * s], x[8 * s + 1]); p[1] = pk2(x[8 * s + 2], x[8 * s + 3]); p[2] = pk2(x[8 * s + 4], x[8 * s + 5]); p[3] = pk2(x[8 * s + 6], x[8 * s + 7]);
    return __builtin_bit_cast(bf16x8, p);
}
struct AttnW { const bf16_t *q, *k, *v; long qs, kvs; int mq0, maxd; unsigned need; };
constexpr float SCL = 0.08838834764831845f * 1.4426950408889634f;

constexpr int HB2 = 32768;
template <int MODE, bool SHARED>
DI void attn_core(LAS unsigned char* lds, const AttnW& w, unsigned selm, int ntrip, f32x16 (&o)[4], float& m_run, float& l_run) {
    const int tid = TID(), lane = tid & 63, r = lane & 31, h = lane >> 5, half = tid >> 8, hl = tid & 255;
    const int wvh = SHARED ? (tid >> 6) : (hl >> 6);
    LAS unsigned char* hb = SHARED ? lds : lds + half * 2 * HB2;
    const int rl = wvh * 4 + (lane >> 4);
    const long koff = (long)rl * w.kvs + (((lane & 15) ^ (rl & 15)) * 8);
    const long voff = (long)rl * w.kvs + (((lane & 15) ^ ((rl & 3) << 2)) * 8);
    auto dma = [&](int tile, int b) {
        const bf16_t* kp = w.k + (long)tile * 64 * w.kvs + koff; const bf16_t* vp = w.v + (long)tile * 64 * w.kvs + voff;
        LAS unsigned char* dst = hb + b * HB2 + wvh * 1024;
        constexpr int NI = SHARED ? 2 : 4, RS = SHARED ? 32 : 16, DS = SHARED ? 8192 : 4096;
#pragma unroll
        for (int i = 0; i < NI; ++i) {
            __builtin_amdgcn_global_load_lds((const unsigned*)(kp + (long)(RS * i) * w.kvs), (LAS unsigned*)(dst + i * DS), 16, 0, 0);
            __builtin_amdgcn_global_load_lds((const unsigned*)(vp + (long)(RS * i) * w.kvs), (LAS unsigned*)(dst + 16384 + i * DS), 16, 0, 0);
        }
    };
    unsigned rem = __builtin_amdgcn_readfirstlane(w.need);
    int tcur = -1;
    if (rem) { tcur = __builtin_ctz(rem); rem &= rem - 1; }
    if (tcur >= 0) dma(tcur, 0);
    bf16x8 qf[8];
    { const bf16_t* qp = w.q + (long)r * w.qs + h * 8;
#pragma unroll
      for (int ks = 0; ks < 8; ++ks) qf[ks] = *(const bf16x8*)(qp + ks * 16); }
#pragma unroll
    for (int db = 0; db < 4; ++db)
#pragma unroll
        for (int i = 0; i < 16; ++i) o[db][i] = 0.f;
    m_run = -INFINITY; l_run = 0.f;
    const int mrow = w.mq0 + r;
    const int i16 = lane & 15, q4 = i16 >> 2, pp = i16 & 3, blk = (lane >> 4) & 1;
    const unsigned kaoff = (unsigned)(r * 256 + (((r & 15) ^ h) << 4));
    const unsigned vaoff = (unsigned)((4 * h + q4) * 256 + (q4 << 6) + blk * 32 + pp * 8);
    asm volatile("s_waitcnt vmcnt(0)" ::: "memory");
    __syncthreads();
    for (int it = 0; it < ntrip; ++it) {
        int tnext = -1;
        if (rem) { tnext = __builtin_ctz(rem); rem &= rem - 1; }
        if (tnext >= 0) dma(tnext, (it + 1) & 1);
        const unsigned Kt = (unsigned)(size_t)(hb + (it & 1) * HB2), Vt = Kt + 16384u;
        const int ts = tcur * 64;
        const bool act = (tcur >= 0) && !((MODE == 0) && (ts > w.mq0 + 31 || ts + 63 < w.mq0 - w.maxd));
        if (act) {
            f32x16 s0, s1;
#pragma unroll
            for (int i = 0; i < 16; ++i) { s0[i] = 0.f; s1[i] = 0.f; }
            const unsigned ka = Kt + kaoff;
#pragma unroll
            for (int ks = 0; ks < 8; ++ks) {
                const bf16x8 a0 = *(LAS const bf16x8*)(size_t)(ka ^ (unsigned)(ks * 32)), a1 = *(LAS const bf16x8*)(size_t)((ka ^ (unsigned)(ks * 32)) + 8192u);
                s0 = MFMA32(a0, qf[ks], s0); s1 = MFMA32(a1, qf[ks], s1);
            }
            const bool full = (MODE == 0) && (ts + 63 <= w.mq0) && (w.mq0 + 31 - ts <= w.maxd);
            float mx = -INFINITY;
            if (full) {
#pragma unroll
                for (int i = 0; i < 16; ++i) { s0[i] *= SCL; s1[i] *= SCL; mx = fmaxf(mx, fmaxf(s0[i], s1[i])); }
            } else {
                const int d0 = mrow - ts - 4 * h; const int dl = d0 - w.maxd;
                const bool lok = (MODE == 1) ? (((selm >> tcur) & 1u) != 0u) : true;
#pragma unroll
                for (int i = 0; i < 16; ++i) {
                    const int ci = (i & 3) + 8 * (i >> 2);
                    const bool v0 = lok && (ci <= d0) && (ci >= dl), v1 = lok && (ci + 32 <= d0) && (ci + 32 >= dl);
                    s0[i] = v0 ? s0[i] * SCL : -INFINITY; s1[i] = v1 ? s1[i] * SCL : -INFINITY;
                    mx = fmaxf(mx, fmaxf(s0[i], s1[i]));
                }
            }
            mx = fmaxf(mx, __shfl_xor(mx, 32));
            const float m_new = fmaxf(m_run, mx); const float m_use = (m_new == -INFINITY) ? 0.f : m_new;
            const float alpha = __builtin_amdgcn_exp2f(m_run - m_use);
            float ls = 0.f;
#pragma unroll
            for (int i = 0; i < 16; ++i) { s0[i] = __builtin_amdgcn_exp2f(s0[i] - m_use); s1[i] = __builtin_amdgcn_exp2f(s1[i] - m_use); ls += s0[i] + s1[i]; }
            ls += __shfl_xor(ls, 32);
            l_run = l_run * alpha + ls; m_run = m_new;
#pragma unroll
            for (int db = 0; db < 4; ++db)
#pragma unroll
                for (int i = 0; i < 16; ++i) o[db][i] *= alpha;
            const unsigned va = Vt + vaoff;
#pragma unroll
            for (int kb = 0; kb < 2; ++kb)
#pragma unroll
                for (int s2 = 0; s2 < 2; ++s2) {
                    const bf16x8 pf = pack8(kb ? s1 : s0, s2);
                    const unsigned vb = va + (unsigned)((kb * 32 + 16 * s2) * 256);
                    const unsigned a0 = vb, a1 = vb ^ 64u, a2 = vb ^ 128u, a3 = vb ^ 192u;
                    s16x4 l0, h0, l1, h1, l2, h2, l3, h3;
                    asm volatile("ds_read_b64_tr_b16 %0, %8\n\tds_read_b64_tr_b16 %1, %8 offset:2048\n\t"
                                 "ds_read_b64_tr_b16 %2, %9\n\tds_read_b64_tr_b16 %3, %9 offset:2048\n\t"
                                 "ds_read_b64_tr_b16 %4, %10\n\tds_read_b64_tr_b16 %5, %10 offset:2048\n\t"
                                 "ds_read_b64_tr_b16 %6, %11\n\tds_read_b64_tr_b16 %7, %11 offset:2048\n\t"
                                 "s_waitcnt lgkmcnt(0)"
                                 : "=&v"(l0), "=&v"(h0), "=&v"(l1), "=&v"(h1), "=&v"(l2), "=&v"(h2), "=&v"(l3), "=&v"(h3)
                                 : "v"(a0), "v"(a1), "v"(a2), "v"(a3) : "memory");
                    o[0] = MFMA32(__builtin_shufflevector(l0, h0, 0, 1, 2, 3, 4, 5, 6, 7), pf, o[0]);
                    o[1] = MFMA32(__builtin_shufflevector(l1, h1, 0, 1, 2, 3, 4, 5, 6, 7), pf, o[1]);
                    o[2] = MFMA32(__builtin_shufflevector(l2, h2, 0, 1, 2, 3, 4, 5, 6, 7), pf, o[2]);
                    o[3] = MFMA32(__builtin_shufflevector(l3, h3, 0, 1, 2, 3, 4, 5, 6, 7), pf, o[3]);
                }
        }
        asm volatile("s_waitcnt vmcnt(0)" ::: "memory");
        __syncthreads();
        tcur = tnext;
    }
}

constexpr int OST_P = 132, OST_B = 32 * OST_P * 4;
DI void stage_o(LAS float* st, const f32x16 (&o)[4], float sc, int r, int h) {
#pragma unroll
    for (int db = 0; db < 4; ++db)
#pragma unroll
        for (int qq = 0; qq < 4; ++qq) { f32x4 v; v[0] = o[db][4 * qq] * sc; v[1] = o[db][4 * qq + 1] * sc; v[2] = o[db][4 * qq + 2] * sc; v[3] = o[db][4 * qq + 3] * sc;
            *(LAS f32x4*)(st + r * OST_P + 32 * db + 8 * qq + 4 * h) = v; }
}
DI void attnA_unit(LAS unsigned char* lds, int u, const bf16_t* UA, bf16_t* OG, float* LSE) {
    const int tid = TID(), lane = tid & 63, r = lane & 31, h = lane >> 5, half = tid >> 8, wv = (tid >> 6) & 3;
    const int g = u >> 8, v = u & 255, bl = v >> 6, hd = (v >> 3) & 7;
    int d, resv[2], m0[2];
    if (g == 0) { d = 1; resv[0] = resv[1] = 0; m0[0] = (v & 7) * 256; m0[1] = m0[0] + 128; }
    else if (g == 1) { d = 4; resv[0] = resv[1] = (v >> 1) & 3; m0[0] = (v & 1) * 256; m0[1] = m0[0] + 128; }
    else { d = 16; resv[0] = (v & 7) * 2; resv[1] = resv[0] + 1; m0[0] = m0[1] = 0; }
    unsigned need[2];
#pragma unroll
    for (int hf = 0; hf < 2; ++hf) { const int lo = (m0[hf] - 128 > 0 ? m0[hf] - 128 : 0) >> 6, hi = (m0[hf] + 127) >> 6; need[hf] = ((2u << hi) - 1u) & ~((1u << lo) - 1u); }
    const int n0 = __builtin_popcount(need[0]), n1 = __builtin_popcount(need[1]);
    const int ntrip = n0 > n1 ? n0 : n1;
    const int m0h = half ? m0[1] : m0[0], res = half ? resv[1] : resv[0];
    const int mq0 = m0h + 32 * wv;
    const long tokbase = (long)bl * 2048 + res;
    AttnW w;
    w.q = UA + ((long)(g * 24 + hd) * 8192 + tokbase + (long)mq0 * d) * 128; w.qs = (long)d * 128;
    w.k = UA + ((long)(g * 24 + 8 + hd) * 8192 + tokbase) * 128; w.v = w.k + (long)8 * 8192 * 128; w.kvs = (long)d * 128;
    w.mq0 = mq0; w.maxd = 128; w.need = half ? need[1] : need[0];
    f32x16 o[4]; float m_run, l_run;
    attn_core<0, false>(lds, w, 0u, ntrip, o, m_run, l_run);
    const float inv = 1.f / l_run;
    const long tok = tokbase + (long)(mq0 + r) * d;
    { LAS float* st = (LAS float*)(lds + (tid >> 6) * OST_B);
      stage_o(st, o, inv, r, h);
      const int ch = lane & 15;
#pragma unroll
      for (int jj = 0; jj < 8; ++jj) { const int rr = 4 * jj + (lane >> 4);
          const f32x4 a = *(LAS const f32x4*)(st + rr * OST_P + ch * 8), bq = *(LAS const f32x4*)(st + rr * OST_P + ch * 8 + 4);
          u32x4 wv; wv[0] = pk2(a[0], a[1]); wv[1] = pk2(a[2], a[3]); wv[2] = pk2(bq[0], bq[1]); wv[3] = pk2(bq[2], bq[3]);
          st16_wt(OG + ((long)g * 8192 + tokbase + (long)(mq0 + rr) * d) * 1024 + hd * 128 + ch * 8, wv); } }
    if (h == 0) LSE[((long)g * 8192 + tok) * 8 + hd] = m_run * 0.6931471805599453f + __logf(l_run);
    __syncthreads();
}

template <int MODE>
DI void attnB_unit(LAS unsigned char* lds, int b, int g, int cur, const bf16_t* UB, const unsigned* SELM, const float* gate_b, bf16_t* Y) {
    const int tid = TID(), lane = tid & 63, r = lane & 31, h = lane >> 5, half = tid >> 8, wv = (tid >> 6) & 3;
    const int hq = g * 4 + wv;
    const int t0h = cur * 64 + 32 * half;
    unsigned need[2]; unsigned selm = 0u;
    if (MODE == 0) {
#pragma unroll
        for (int hf = 0; hf < 2; ++hf) { const int tt = cur * 64 + 32 * hf; const int lo = (tt - 511 > 0 ? tt - 511 : 0) >> 6; need[hf] = ((2u << cur) - 1u) & ~((1u << lo) - 1u); }
    } else {
        unsigned mk = SELM[((size_t)(b * 2 + g)) * 2048 + cur * 64 + lane];
        selm = __shfl(mk, (lane & 31) + 32 * half);
#pragma unroll
        for (int s = 1; s < 32; s <<= 1) mk |= __shfl_xor(mk, s);
        need[0] = __shfl(mk, 0); need[1] = __shfl(mk, 32);
    }
    const unsigned needu = need[0] | need[1];
    const int ntrip = __builtin_popcount(needu);
    const size_t tokb = (size_t)b * 2048;
    AttnW w;
    w.q = UB + ((size_t)hq * 32768 + tokb + t0h) * 128; w.qs = 128;
    w.k = UB + ((size_t)((MODE == 0 ? 12 : 8) + g) * 32768 + tokb) * 128; w.v = w.k + (size_t)2 * 32768 * 128; w.kvs = 128;
    w.mq0 = t0h; w.maxd = (MODE == 0) ? 511 : 1 << 20; w.need = needu;
    f32x16 o[4]; float m_run, l_run;
    attn_core<MODE, true>(lds, w, selm, ntrip, o, m_run, l_run);
    const size_t tok = tokb + t0h + r;
    const int gi = hq * 3 + (MODE == 0 ? 2 : 1);
    const bf16_t* UBZ = UB + (size_t)16 * 32768 * 128;
    const float gt = sigm(bf2f(UBZ[tok * 1056 + 1024 + gi]) + gate_b[gi]);
    const float sc = gt / l_run;
    { LAS float* st = (LAS float*)(lds + (tid >> 6) * OST_B);
      stage_o(st, o, sc, r, h);
      const int ch = lane & 15;
      u32x4 oldv[8], zzv[8];
      if (MODE == 1) {
#pragma unroll
          for (int jj = 0; jj < 8; ++jj) { const size_t tk = tokb + t0h + 4 * jj + (lane >> 4);
              oldv[jj] = *(const u32x4*)(Y + tk * 1024 + hq * 128 + ch * 8); zzv[jj] = *(const u32x4*)(UBZ + tk * 1056 + hq * 128 + ch * 8); }
          asm volatile("" ::: "memory");
      }
#pragma unroll
      for (int jj = 0; jj < 8; ++jj) { const int rr = 4 * jj + (lane >> 4); const size_t tk = tokb + t0h + rr;
          f32x4 a = *(LAS const f32x4*)(st + rr * OST_P + ch * 8), bq = *(LAS const f32x4*)(st + rr * OST_P + ch * 8 + 4);
          bf16_t* yq = Y + tk * 1024 + hq * 128 + ch * 8;
          if (MODE == 1) {
              const u32x4 old = oldv[jj], zz = zzv[jj];
              a[0] = (a[0] + bflo(old[0])) * silu(bflo(zz[0])); a[1] = (a[1] + bfhi(old[0])) * silu(bfhi(zz[0])); a[2] = (a[2] + bflo(old[1])) * silu(bflo(zz[1])); a[3] = (a[3] + bfhi(old[1])) * silu(bfhi(zz[1]));
              bq[0] = (bq[0] + bflo(old[2])) * silu(bflo(zz[2])); bq[1] = (bq[1] + bfhi(old[2])) * silu(bfhi(zz[2])); bq[2] = (bq[2] + bflo(old[3])) * silu(bflo(zz[3])); bq[3] = (bq[3] + bfhi(old[3])) * silu(bfhi(zz[3]));
          }
          u32x4 wv; wv[0] = pk2(a[0], a[1]); wv[1] = pk2(a[2], a[3]); wv[2] = pk2(bq[0], bq[1]); wv[3] = pk2(bq[2], bq[3]);
          st16_wt(yq, wv); } }
    __syncthreads();
}

DI void attnCmp_unit(LAS unsigned char* lds, int b, int g, int cur, const bf16_t* UB, const bf16_t* KC, const bf16_t* VC, const float* gate_b, bf16_t* Y, unsigned* SELM) {
    const int tid = TID(), lane = tid & 63, r = lane & 31, h = lane >> 5, wid = tid >> 6, wv = wid & 3, th = wid >> 2;
    const int hq = g * 4 + wv;
    const int t0 = cur * 64 + 32 * th;
    constexpr int CK_B = 128 * KT_P, CV_B = 128 * VT_P;
    LAS unsigned char* Kt = lds; LAS unsigned char* Vt = lds + CK_B; LAS float* arr = (LAS float*)(lds + CK_B + CV_B);
    LAS float* score = arr + 8 * 32 * 32;
    { const bf16_t* kp = KC + (size_t)(b * 2 + g) * 128 * 128; const bf16_t* vp = VC + (size_t)(b * 2 + g) * 128 * 128;
      const int skey = tid >> 4, spart = tid & 15;
#pragma unroll
      for (int i = 0; i < 4; ++i) { const int key = skey + 32 * i;
          *(LAS u32x4*)(Kt + key * KT_P + spart * 16) = *(const u32x4*)(kp + key * 128 + spart * 8);
          *(LAS u32x4*)(Vt + key * VT_P + spart * 16) = *(const u32x4*)(vp + key * 128 + spart * 8); } }
    const size_t tokb = (size_t)b * 2048;
    bf16x8 qf[8];
    { const bf16_t* qp = UB + ((size_t)hq * 32768 + tokb + t0 + r) * 128 + h * 8;
#pragma unroll
      for (int ks = 0; ks < 8; ++ks) qf[ks] = *(const bf16x8*)(qp + ks * 16); }
    __syncthreads();
    f32x16 s[4];
#pragma unroll
    for (int kb = 0; kb < 4; ++kb) {
#pragma unroll
        for (int i = 0; i < 16; ++i) s[kb][i] = 0.f;
        LAS const unsigned char* ka = Kt + (kb * 32 + r) * KT_P + h * 16;
#pragma unroll
        for (int ks = 0; ks < 8; ++ks) s[kb] = MFMA32(*(LAS const bf16x8*)(ka + ks * 32), qf[ks], s[kb]);
    }
    const int t = t0 + r;
    const int jmax = (t >= 31) ? ((t - 31) >> 4) : -1;
    float mx = -INFINITY;
#pragma unroll
    for (int kb = 0; kb < 4; ++kb)
#pragma unroll
        for (int i = 0; i < 16; ++i) { const int j = 32 * kb + (i & 3) + 8 * (i >> 2) + 4 * h; s[kb][i] = (j <= jmax) ? s[kb][i] * SCL : -INFINITY; mx = fmaxf(mx, s[kb][i]); }
    mx = fmaxf(mx, __shfl_xor(mx, 32));
    const float m_use = (mx == -INFINITY) ? 0.f : mx;
    float ls = 0.f;
#pragma unroll
    for (int kb = 0; kb < 4; ++kb)
#pragma unroll
        for (int i = 0; i < 16; ++i) { s[kb][i] = __builtin_amdgcn_exp2f(s[kb][i] - m_use); ls += s[kb][i]; }
    ls += __shfl_xor(ls, 32);
    const float inv = 1.f / fmaxf(ls, 1e-30f);
#pragma unroll
    for (int kb = 0; kb < 4; ++kb)
#pragma unroll
        for (int i = 0; i < 16; ++i) s[kb][i] *= inv;
    {
        LAS float* ap = arr + (wid * 32 + r) * 32;
#pragma unroll
        for (int kb = 0; kb < 4; ++kb)
#pragma unroll
            for (int qd = 0; qd < 4; ++qd) {
                const float qs = s[kb][4 * qd] + s[kb][4 * qd + 1] + s[kb][4 * qd + 2] + s[kb][4 * qd + 3];
                const float lastv = s[kb][4 * qd + 3];
                const float prevsame = (kb == 0 && qd == 0) ? 0.f : ((qd == 0) ? s[kb - (kb > 0)][15] : s[kb][4 * qd - 1]);
                const float send = h ? prevsame : lastv;
                const float recv = __shfl_xor(send, 32);
                ap[8 * kb + 2 * qd + h] = qs + recv;
            }
    }
    f32x16 o[4];
#pragma unroll
    for (int db = 0; db < 4; ++db)
#pragma unroll
        for (int i = 0; i < 16; ++i) o[db][i] = 0.f;
    {
        const int i16 = lane & 15, q4 = i16 >> 2, pp = i16 & 3, blk = (lane >> 4) & 1;
        LAS const unsigned char* va = Vt + (4 * h + q4) * VT_P + (16 * blk + 4 * pp) * 2;
#pragma unroll
        for (int kb = 0; kb < 4; ++kb)
#pragma unroll
            for (int s2 = 0; s2 < 2; ++s2) {
                const bf16x8 pf = pack8(s[kb], s2);
                LAS const unsigned char* vb = va + (kb * 32 + 16 * s2) * VT_P;
#pragma unroll
                for (int db = 0; db < 4; ++db) {
                    const s16x4 lo = trrd(vb + db * 64), hi = trrd(vb + 8 * VT_P + db * 64);
                    o[db] = MFMA32(__builtin_shufflevector(lo, hi, 0, 1, 2, 3, 4, 5, 6, 7), pf, o[db]);
                }
            }
    }
    __syncthreads();
#pragma unroll
    for (int i = 0; i < 4; ++i) {
        const int pidx = tid + 512 * i, tt = pidx >> 5, n = pidx & 31;
        const int wb = (tt >> 5) * 4, tr_ = tt & 31;
        float sc = arr[((wb + 0) * 32 + tr_) * 32 + n] + arr[((wb + 1) * 32 + tr_) * 32 + n] + arr[((wb + 2) * 32 + tr_) * 32 + n] + arr[((wb + 3) * 32 + tr_) * 32 + n];
        if (n > cur) sc = -INFINITY; else if (n == 0 || n == cur || n == cur - 1) sc = 1000.f;
        score[tt * 32 + n] = sc;
    }
    __syncthreads();
#pragma unroll
    for (int i = 0; i < 4; ++i) {
        const int pidx = tid + 512 * i, tt = pidx >> 5, n = pidx & 31;
        const float me = score[tt * 32 + n];
        int rank = 0;
        for (int n2 = 0; n2 < 32; ++n2) { const float ot = score[tt * 32 + n2]; rank += (ot > me || (ot == me && n2 < n)) ? 1 : 0; }
        const bool selb = (n <= cur) && (rank < 16);
        const unsigned long long bal = __ballot(selb);
        if ((lane & 31) == 0) SELM[((size_t)(b * 2 + g)) * 2048 + cur * 64 + tt] = (unsigned)(lane ? (bal >> 32) : (bal & 0xffffffffull));
    }
    __syncthreads();
    {
        const size_t tok = tokb + t;
        const int gi = hq * 3;
        const float gt = sigm(bf2f(UB[(size_t)16 * 32768 * 128 + tok * 1056 + 1024 + gi]) + gate_b[gi]);
        LAS float* st = (LAS float*)(lds + wid * OST_B);
        stage_o(st, o, gt, r, h);
        const int ch = lane & 15;
        u32x4 oldv[8];
#pragma unroll
        for (int jj = 0; jj < 8; ++jj) oldv[jj] = *(const u32x4*)(Y + (tokb + t0 + 4 * jj + (lane >> 4)) * 1024 + hq * 128 + ch * 8);
        asm volatile("" ::: "memory");
#pragma unroll
        for (int jj = 0; jj < 8; ++jj) { const int rr = 4 * jj + (lane >> 4); const size_t tk = tokb + t0 + rr;
            const f32x4 a = *(LAS const f32x4*)(st + rr * OST_P + ch * 8), bq = *(LAS const f32x4*)(st + rr * OST_P + ch * 8 + 4);
            bf16_t* yq = Y + tk * 1024 + hq * 128 + ch * 8;
            const u32x4 old = oldv[jj];
            u32x4 wv; wv[0] = pk2(a[0] + bflo(old[0]), a[1] + bfhi(old[0])); wv[1] = pk2(a[2] + bflo(old[1]), a[3] + bfhi(old[1]));
            wv[2] = pk2(bq[0] + bflo(old[2]), bq[1] + bfhi(old[2])); wv[3] = pk2(bq[2] + bflo(old[3]), bq[3] + bfhi(old[3]));
            st16_wt(yq, wv); }
    }
    __syncthreads();
}

DI float wave_sum(float v) {
#pragma unroll
    for (int s = 32; s > 0; s >>= 1) v += __shfl_xor(v, s);
    return v;
}
template <bool FINAL>
DI void norm_phase(PR p, const float* x, const float* gain, bf16_t* xb, float* outp) {
    const int tid_ = TID(); const int lane = tid_ & 63, wid = tid_ >> 6;
    f32x4 gg[4];
#pragma unroll
    for (int i = 0; i < 4; ++i) gg[i] = *(const f32x4*)(gain + lane * 4 + 256 * i);
    constexpr int NR = 4;
    for (int row0 = (BID() * 8 + wid) * NR; row0 < 32768; row0 += NBLK() * 8 * NR) {
        f32x4 v[NR][4]; float ss[NR];
#pragma unroll
        for (int q = 0; q < NR; ++q)
#pragma unroll
            for (int i = 0; i < 4; ++i) v[q][i] = *(const f32x4*)(x + (size_t)(row0 + q) * 1024 + lane * 4 + 256 * i);
#pragma unroll
        for (int q = 0; q < NR; ++q) { ss[q] = 0.f;
#pragma unroll
            for (int i = 0; i < 4; ++i) ss[q] += v[q][i][0] * v[q][i][0] + v[q][i][1] * v[q][i][1] + v[q][i][2] * v[q][i][2] + v[q][i][3] * v[q][i][3];
            ss[q] = wave_sum(ss[q]); }
#pragma unroll
        for (int q = 0; q < NR; ++q) {
            const float rs = rsqrtf(ss[q] * (1.f / 1024.f) + 1e-6f);
#pragma unroll
            for (int i = 0; i < 4; ++i) {
                const f32x4 y = v[q][i] * rs * gg[i];
                if (FINAL) st16f_wt(outp + (size_t)(row0 + q) * 1024 + lane * 4 + 256 * i, y);
                else { u32x2 w; w[0] = pk2(y[0], y[1]); w[1] = pk2(y[2], y[3]); st8_wt(xb + (size_t)(row0 + q) * 1024 + lane * 4 + 256 * i, w); }
            }
        }
    }
}

struct TJob { const float* src; bf16_t* dst; int K, N, Npad, ldd, mode; };
DI int head_perm(int pos) { const int wc = pos >> 5, fq = (pos >> 3) & 3, e = pos & 7; return fq == 0 ? (e < 4 ? 4 * wc + e : 12 + 4 * wc + e) : 32 + (wc * 3 + fq - 1) * 8 + e; }
DI int src_col(int mode, int n) {
    const int hh = n >> 7; bool pm = false;
    if (mode == 1) pm = hh < 72 && ((hh % 24) < 16);
    if (mode == 2) pm = hh < 8 || hh == 12 || hh == 13 || hh == 16 || hh == 17;
    if (mode == 3) pm = true;
    return pm ? (hh << 7) + head_perm(n & 127) : n;
}
DI TJob get_job(PR p, int id) {
    unsigned char* ws = p.ws; TJob j;
    if (id < 2) j = {p.a_w_in + (size_t)id * 1024 * 10240, (bf16_t*)(ws + OFF_WAIN) + (size_t)id * 10240 * 1024, 1024, 10240, 10240, 1024, 1};
    else if (id < 4) j = {p.a_w_out + (size_t)(id - 2) * 1024 * 1024, (bf16_t*)(ws + OFF_WAOUT) + (size_t)(id - 2) * 1024 * 1024, 1024, 1024, 1024, 1024, 0};
    else if (id == 4) j = {p.b_w_in, (bf16_t*)(ws + OFF_WBIN), 1024, 3608, 3840, 1024, 2};
    else if (id == 5) j = {p.b_w_out, (bf16_t*)(ws + OFF_WBOUT), 1024, 1024, 1024, 1024, 0};
    else if (id == 6) j = {p.c_w_in, (bf16_t*)(ws + OFF_WCIN), 1024, 2560, 2560, 1024, 0};
    else if (id == 7) j = {p.c_w_out, (bf16_t*)(ws + OFF_WCOUT), 1280, 1024, 1024, 1280, 0};
    else if (id == 8) j = {p.b_w1_k, (bf16_t*)(ws + OFF_WCMP1), 4096, 128, 128, 4096, 0};
    else if (id == 9) j = {p.b_w1_v, (bf16_t*)(ws + OFF_WCMP1) + (size_t)128 * 4096, 4096, 128, 128, 4096, 0};
    else if (id == 10) j = {p.b_w2_k, (bf16_t*)(ws + OFF_WCMP2), 128, 128, 128, 256, 3};
    else if (id == 11) j = {p.b_w2_v, (bf16_t*)(ws + OFF_WCMP2) + 128 * 256 + 128, 128, 128, 128, 256, 0};
    else if (id == 12) j = {p.b_w2_k, (bf16_t*)(ws + OFF_WCMP2) + 128, 128, 0, 128, 256, 0};
    else if (id == 13) j = {p.b_w2_k, (bf16_t*)(ws + OFF_WCMP2) + 128 * 256, 128, 0, 128, 256, 0};
    else if (id < 24) j = {p.c_wa + (size_t)(id - 14) * 128 * 128, (bf16_t*)(ws + OFF_WGATE) + (size_t)(id - 14) * 256 * 128, 128, 128, 128, 128, 0};
    else j = {p.c_wx + (size_t)(id - 24) * 128 * 128, (bf16_t*)(ws + OFF_WGATE) + (size_t)(id - 24) * 256 * 128 + 128 * 128, 128, 128, 128, 128, 0};
    return j;
}
DI void prep_phase(PR p, LAS unsigned char* lds) {
    const int tid = TID();
    LAS float* sm = (LAS float*)lds;
    int rot = 0;
    const int nbk = NBLK(), bidk = BID();
    for (int id = 0; id < 34; ++id) {
        const TJob j = get_job(p, id);
        const int tk = j.K / 64, ntile = tk * (j.Npad / 64);
        int t0 = bidk - rot; if (t0 < 0) t0 += nbk;
        rot = (rot + ntile) % nbk;
        for (int tile = t0; tile < ntile; tile += nbk) {
            const int k0 = (tile % tk) * 64, n0 = (tile / tk) * 64;
#pragma unroll
            for (int i = 0; i < 8; ++i) { const int idx = tid + 512 * i, kk = idx >> 6, nn = idx & 63;
                sm[kk * 65 + nn] = (n0 + nn < j.N) ? j.src[(size_t)(k0 + kk) * j.N + src_col(j.mode, n0 + nn)] : 0.f; }
            __syncthreads();
#pragma unroll
            for (int i = 0; i < 4; ++i) { const int idx = tid + 512 * i, nn = idx >> 5, kp = idx & 31;
                *(unsigned*)(j.dst + (size_t)(n0 + nn) * j.ldd + k0 + 2 * kp) = pk2(sm[(2 * kp) * 65 + nn], sm[(2 * kp + 1) * 65 + nn]); }
            __syncthreads();
        }
    }
    { float* rt = (float*)(p.ws + OFF_ROPE);
      for (int idx = BID() * 512 + tid; idx < 2048 * 16; idx += NBLK() * 512) { const int t = idx >> 4, i = idx & 15;
          const float inv_freq = powf(500000.f, -2.f * (float)i / 32.f); const float ang = (float)t * inv_freq;
          rt[t * 32 + i] = cosf(ang); rt[t * 32 + 16 + i] = sinf(ang); } }
    if (BID() == 0) { float* sp = (float*)(p.ws + OFF_SP8); for (int c = tid; c < 1280; c += 512) sp[c] = -8.f * log1pf(expf(-p.c_lambda[c])); }
    if (tid < 256) {
        const int e = tid & 127, which = tid >> 7;
        const float* pe = which ? p.b_pe_v : p.b_pe_k; const float* w1 = which ? p.b_w1_v : p.b_w1_k;
        float a = 0.f;
        for (int pd = BID(); pd < 4096; pd += NBLK()) a += pe[pd] * w1[(size_t)pd * 128 + e];
        ((float*)(p.ws + OFF_BPART))[(size_t)BID() * 256 + tid] = a;
    }
    norm_phase<false>(p, p.x, p.norm_g, (bf16_t*)(p.ws + OFF_XB), nullptr);
}

DI void mergeA_phase(PR p, int row0g) {
    const bf16_t* OG = (const bf16_t*)(p.ws + OFF_OG); const float* LSE = (const float*)(p.ws + OFF_LSE);
    const bf16_t* ZA = (const bf16_t*)(p.ws + OFF_ZA); bf16_t* Y = (bf16_t*)(p.ws + OFF_XB);
    for (int idx = BID() * 512 + TID(); idx < 8192 * 128; idx += NBLK() * 512) {
        const int tokl = idx >> 7, c8 = idx & 127, hd = c8 >> 4, col = c8 * 8;
        const float l0 = LSE[((size_t)0 * 8192 + tokl) * 8 + hd], l1 = LSE[((size_t)1 * 8192 + tokl) * 8 + hd], l2 = LSE[((size_t)2 * 8192 + tokl) * 8 + hd];
        const float mx = fmaxf(l0, fmaxf(l1, l2));
        float w0 = __expf(l0 - mx), w1 = __expf(l1 - mx), w2 = __expf(l2 - mx);
        const float inv = 1.f / (w0 + w1 + w2); w0 *= inv; w1 *= inv; w2 *= inv;
        const u32x4 a0 = *(const u32x4*)(OG + ((size_t)0 * 8192 + tokl) * 1024 + col), a1 = *(const u32x4*)(OG + ((size_t)1 * 8192 + tokl) * 1024 + col), a2 = *(const u32x4*)(OG + ((size_t)2 * 8192 + tokl) * 1024 + col);
        const u32x4 zz = *(const u32x4*)(ZA + (size_t)(row0g + tokl) * 1024 + col);
        u32x4 out;
#pragma unroll
        for (int e = 0; e < 4; ++e) {
            const float lo = (w0 * bflo(a0[e]) + w1 * bflo(a1[e]) + w2 * bflo(a2[e])) * silu(bflo(zz[e]));
            const float hi = (w0 * bfhi(a0[e]) + w1 * bfhi(a1[e]) + w2 * bfhi(a2[e])) * silu(bfhi(zz[e]));
            out[e] = pk2(lo, hi);
        }
        st16_wt(Y + (size_t)(row0g + tokl) * 1024 + col, out);
    }
}

DI void gate_phase(PR p, LAS unsigned char* lds) {
    const int tid = TID(), lane = tid & 63, wid = tid >> 6, r = lane & 31, h = lane >> 5;
    const int c = BID(), qg = NBLK() / 10;
    if (c >= qg * 10) return;
    const int n = c % 10;
    const bf16_t* Bt = (const bf16_t*)(p.ws + OFF_WGATE) + (size_t)n * 256 * 128;
    bf16_t* XC = (bf16_t*)(p.ws + OFF_XC); unsigned* AB = (unsigned*)(p.ws + OFF_AB); const bf16_t* XR = (const bf16_t*)(p.ws + OFF_XRAW);
#pragma unroll
    for (int i = 0; i < 8; ++i) { const int idx = tid + 512 * i, row = idx >> 4, part = idx & 15;
        *(LAS u32x4*)(lds + row * KT_P + part * 16) = *(const u32x4*)(Bt + row * 128 + part * 8); }
    LAS float* cwl0 = (LAS float*)(lds + 256 * KT_P);
    for (int idx = tid; idx < 640; idx += 512) { const int w = idx >> 7, c = idx & 127; cwl0[idx] = (w < 4) ? p.c_conv_w[w * 1280 + n * 128 + c] : p.c_conv_b[n * 128 + c]; }
    __syncthreads();
    const float* ba = p.c_ba + n * 128; const float* bx = p.c_bx + n * 128; const float* sp8 = (const float*)(p.ws + OFF_SP8) + n * 128;
    for (int pm = c / 10; pm < 128; pm += qg) {
        const size_t row = (size_t)pm * 256 + wid * 32 + r;
        const int t = (int)(row & 2047);
        bf16x8 af[8];
#pragma unroll
        for (int ks = 0; ks < 8; ++ks) {
            const int c0 = n * 128 + ks * 16 + h * 8;
            LAS const float* cwl = cwl0 + ks * 16 + h * 8;
            const f32x4 b0 = *(LAS const f32x4*)(cwl + 512), b1 = *(LAS const f32x4*)(cwl + 516);
            float a[8] = {b0[0], b0[1], b0[2], b0[3], b1[0], b1[1], b1[2], b1[3]};
#pragma unroll
            for (int w = 0; w < 4; ++w) {
                if (t + w - 3 < 0) continue;
                const u32x4 xv = *(const u32x4*)(XR + (row + w - 3) * 1280 + c0);
                const f32x4 w0 = *(LAS const f32x4*)(cwl + w * 128), w1 = *(LAS const f32x4*)(cwl + w * 128 + 4);
                a[0] += w0[0] * bflo(xv[0]); a[1] += w0[1] * bfhi(xv[0]); a[2] += w0[2] * bflo(xv[1]); a[3] += w0[3] * bfhi(xv[1]);
                a[4] += w1[0] * bflo(xv[2]); a[5] += w1[1] * bfhi(xv[2]); a[6] += w1[2] * bflo(xv[3]); a[7] += w1[3] * bfhi(xv[3]);
            }
            u32x4 o; o[0] = pk2(a[0], a[1]); o[1] = pk2(a[2], a[3]); o[2] = pk2(a[4], a[5]); o[3] = pk2(a[6], a[7]);
            af[ks] = __builtin_bit_cast(bf16x8, o);
            if ((ks & 3) == 3) asm volatile("" ::: "memory");
        }
#pragma unroll
        for (int ob = 0; ob < 4; ++ob) {
            f32x16 ar, ai;
#pragma unroll
            for (int i = 0; i < 16; ++i) { ar[i] = 0.f; ai[i] = 0.f; }
            asm volatile("" ::: "memory");
            LAS const unsigned char* bp = lds + (32 * ob + r) * KT_P + h * 16;
#pragma unroll
            for (int ks = 0; ks < 8; ++ks) {
                const bf16x8 br = *(LAS const bf16x8*)(bp + ks * 32), bi = *(LAS const bf16x8*)(bp + 128 * KT_P + ks * 32);
                ar = MFMA32(br, af[ks], ar); ai = MFMA32(bi, af[ks], ai);
            }
#pragma unroll
            for (int q4 = 0; q4 < 4; ++q4) {
                const int chl = 32 * ob + 8 * q4 + 4 * h;
                const f32x4 vba = *(const f32x4*)(ba + chl), vbx = *(const f32x4*)(bx + chl), sp = *(const f32x4*)(sp8 + chl);
                const u32x4 fw = __builtin_bit_cast(u32x4, af[2 * ob + (q4 >> 1)]);
                const unsigned own0 = h ? fw[2] : fw[0], own1 = h ? fw[3] : fw[1], snd0 = h ? fw[0] : fw[2], snd1 = h ? fw[1] : fw[3];
                const unsigned rc0 = __shfl_xor(snd0, 32), rc1 = __shfl_xor(snd1, 32);
                const unsigned x0 = (h == (q4 & 1)) ? own0 : rc0, x1 = (h == (q4 & 1)) ? own1 : rc1;
                const float xv[4] = {bflo(x0), bfhi(x0), bflo(x1), bfhi(x1)};
                u32x4 w;
#pragma unroll
                for (int e = 0; e < 4; ++e) {
                    const float la = sigm(ar[4 * q4 + e] + vba[e]) * sp[e];
                    const float a2 = __builtin_amdgcn_exp2f(la * 2.8853900817779268f);
                    const float bb = __builtin_sqrtf(fmaxf(1.f - a2, 0.f)) * sigm(ai[4 * q4 + e] + vbx[e]) * xv[e];
                    w[e] = pk2(la, bb);
                }
                *(u32x4*)(AB + row * 1280 + n * 128 + chl) = w;
            }
        }
    }
}
DI void conv_phase(PR p) {
    const bf16_t* XR = (const bf16_t*)(p.ws + OFF_XRAW); bf16_t* XC = (bf16_t*)(p.ws + OFF_XC);
    for (int idx = BID() * 512 + TID(); idx < 32768 * 160; idx += NBLK() * 512) {
        const int tok = idx / 160, c0 = (idx % 160) * 8, t = tok & 2047;
        float a[8];
#pragma unroll
        for (int e = 0; e < 8; ++e) a[e] = p.c_conv_b[c0 + e];
#pragma unroll
        for (int w = 0; w < 4; ++w) {
            if (t + w - 3 < 0) continue;
            const u32x4 xv = *(const u32x4*)(XR + (size_t)(tok + w - 3) * 1280 + c0);
            const float* cw = p.c_conv_w + w * 1280 + c0;
#pragma unroll
            for (int e = 0; e < 4; ++e) { a[2 * e] += cw[2 * e] * bflo(xv[e]); a[2 * e + 1] += cw[2 * e + 1] * bfhi(xv[e]); }
        }
        u32x4 o; o[0] = pk2(a[0], a[1]); o[1] = pk2(a[2], a[3]); o[2] = pk2(a[4], a[5]); o[3] = pk2(a[6], a[7]);
        *(u32x4*)(XC + (size_t)tok * 1280 + c0) = o;
    }
}
template <int PASS>
DI void scan_phase(PR p) {
    const unsigned* AB = (const unsigned*)(p.ws + OFF_AB); f32x2* CARRY = (f32x2*)(p.ws + OFF_CARRY);
    const bf16_t* ZC = (const bf16_t*)(p.ws + OFF_ZC); bf16_t* Y = (bf16_t*)(p.ws + OFF_XRAW);
    const bf16_t* XC = (const bf16_t*)(p.ws + OFF_XC); const float* SP8 = (const float*)(p.ws + OFF_SP8);
    const int tid = TID();
    const int nch = (tid < 256) ? 3 : 2;
    for (int item = BID(); item < 512; item += NBLK()) {
        const int b = item >> 5, ck = item & 31;
        float hh[3] = {0.f, 0.f, 0.f}, P[3] = {1.f, 1.f, 1.f}, sp[3];
#pragma unroll
        for (int k = 0; k < 3; ++k) sp[k] = (k < nch) ? SP8[tid + 512 * k] * 1.4426950408889634f : 0.f;
        if (PASS == 1) {
            for (int c0 = 0; c0 < ck; c0 += 8) {
                f32x2 cv[8][3];
#pragma unroll
                for (int q = 0; q < 8; ++q)
#pragma unroll
                    for (int k = 0; k < 3; ++k) { cv[q][k][0] = 1.f; cv[q][k][1] = 0.f; if (k < nch && c0 + q < ck) cv[q][k] = CARRY[((size_t)(b * 32 + c0 + q)) * 1280 + tid + 512 * k]; }
#pragma unroll
                for (int q = 0; q < 8; ++q)
#pragma unroll
                    for (int k = 0; k < 3; ++k) hh[k] = cv[q][k][0] * hh[k] + cv[q][k][1];
            }
        }
        const size_t base = ((size_t)b * 2048 + ck * 64) * 1280 + tid;
        for (int tb = 0; tb < 4; ++tb) {
            unsigned ab[3][16]; bf16_t zz[3][16];
#pragma unroll
            for (int k = 0; k < 3; ++k)
#pragma unroll
                for (int j = 0; j < 16; ++j) if (k < nch) { const size_t o = base + (size_t)(tb * 16 + j) * 1280 + 512 * k; ab[k][j] = AB[o]; if (PASS == 1) zz[k][j] = ZC[o]; }
#pragma unroll
            for (int k = 0; k < 3; ++k)
#pragma unroll
                for (int j = 0; j < 16; ++j) if (k < nch) {
                    const float a = __builtin_amdgcn_exp2f(bflo(ab[k][j]) * 1.4426950408889634f);
                    const float bb = bfhi(ab[k][j]);
                    hh[k] = a * hh[k] + bb; P[k] *= a;
                    if (PASS == 1) { const size_t o = base + (size_t)(tb * 16 + j) * 1280 + 512 * k; Y[o] = (bf16_t)(pk2(hh[k] * silu(bf2f(zz[k][j])), 0.f) & 0xffffu); }
                }
        }
        if (PASS == 0) {
#pragma unroll
            for (int k = 0; k < 3; ++k) if (k < nch) { f32x2 c; c[0] = P[k]; c[1] = hh[k]; CARRY[((size_t)(b * 32 + ck)) * 1280 + tid + 512 * k] = c; }
        }
    }
}

#define XB_TMO      128
#define XB_XCNT(j)  (256  + 64 * (j))
#define XB_XSUB(j)  (1280 + 64 * (j))
#define XB_XGEN(j)  (2304 + 64 * (j))
#define XB_TOP      3328
#define XB_TOPGEN   3392
#define XCD_BAR_WORDS 3456
#define XB_SPIN_CAP (1u << 22)
DI unsigned xb_ld(unsigned* p) { return __hip_atomic_load(p, __ATOMIC_RELAXED, __HIP_MEMORY_SCOPE_AGENT); }
DI unsigned xb_add(unsigned* p, unsigned v) { return __hip_atomic_fetch_add(p, v, __ATOMIC_RELAXED, __HIP_MEMORY_SCOPE_AGENT); }
DI unsigned xb_xcc_id() { return (unsigned)__builtin_amdgcn_s_getreg((3 << 11) | 20) & 0xFu; }
#define XB_SPIN(cond, bar) do { unsigned _sp = 0; while (cond) { __builtin_amdgcn_s_sleep(1); \
    if ((++_sp & 255u) == 0u) { if (xb_ld(&(bar)[XB_TMO])) break; if (_sp > XB_SPIN_CAP) { atomicAdd(&(bar)[XB_TMO], 1u); break; } } } } while (0)
struct XcdBarrier { unsigned* bar; unsigned x; volatile LAS unsigned* st; };
DI XcdBarrier xcd_barrier_post(unsigned* bar, volatile LAS unsigned* st) {
    XcdBarrier b; b.bar = bar; b.x = xb_xcc_id(); b.st = st;
    if (threadIdx.x == 0) (void)xb_add(&bar[XB_XCNT(b.x)], 1u);
    return b;
}
DI void xcd_barrier_complete(unsigned* bar, unsigned x, unsigned& nloc, unsigned& nx) {
    const unsigned G = gridDim.x * gridDim.y * gridDim.z;
    unsigned sum, cnt, mine, sp = 0u;
    for (;;) {
        sum = 0u; cnt = 0u; mine = 0u;
#pragma unroll
        for (unsigned j = 0; j < 16; ++j) { const unsigned c = xb_ld(&bar[XB_XCNT(j)]); sum += c; cnt += (c > 0u) ? 1u : 0u; mine = (j == x) ? c : mine; }
        if (sum == G) break;
        __builtin_amdgcn_s_sleep(1);
        if ((++sp & 255u) == 0u) { if (xb_ld(&bar[XB_TMO])) break; if (sp > XB_SPIN_CAP) { atomicAdd(&bar[XB_TMO], 1u); break; } }
    }
    nloc = mine > 0u ? mine : 1u; nx = cnt > 0u ? cnt : 1u;
}
DI void xcd_barrier(const XcdBarrier& b) {
    asm volatile("s_waitcnt vmcnt(0)" ::: "memory");
    __syncthreads();
    if (threadIdx.x == 0) {
        unsigned* bar = b.bar;
        __builtin_amdgcn_s_waitcnt(0);
        unsigned nloc = b.st[0], nx = b.st[1];
        if (nloc == 0u) { xcd_barrier_complete(bar, b.x, nloc, nx); b.st[0] = nloc; b.st[1] = nx; }
        const unsigned old = xb_add(&bar[XB_XSUB(b.x)], 1u);
        const unsigned gen = old / nloc;
        if (old + 1u == (gen + 1u) * nloc) {
            __builtin_amdgcn_fence(__ATOMIC_RELEASE, "agent");
            asm volatile("s_waitcnt vmcnt(0)" ::: "memory");
            const unsigned og = xb_add(&bar[XB_TOP], 1u);
            const unsigned tg = og / nx;
            if (og + 1u == (tg + 1u) * nx) xb_add(&bar[XB_TOPGEN], 1u);
            else XB_SPIN(xb_ld(&bar[XB_TOPGEN]) == tg, bar);
            __builtin_amdgcn_fence(__ATOMIC_ACQUIRE, "agent");
            xb_add(&bar[XB_XGEN(b.x)], 1u);
            asm volatile("s_waitcnt vmcnt(0)" ::: "memory");
        } else {
            XB_SPIN(xb_ld(&bar[XB_XGEN(b.x)]) == gen, bar);
            __builtin_amdgcn_fence(__ATOMIC_ACQUIRE, "agent");
            asm volatile("s_waitcnt vmcnt(0)" ::: "memory");
        }
    }
    __syncthreads();
}

constexpr int PH_A0 = 1, PH_B = 12, PH_C = 19, PH_A1 = 25, PH_END = 36;

template <class Epi> DI void run_gemm(PR p, LAS unsigned char* lds, const bf16_t* A, const bf16_t* Bt, int M, int N, int K, int lda, int apn, const Epi& E) {
    pg8::Gemm g; g.A = A; g.Bt = Bt; g.M = M; g.N = N; g.K = K; g.lda = lda; g.apn = apn;
    pg8::StaticOrder S; S.init(M, N, NBLK(), BID());
    pg8::gemm_phase<Epi>(lds, g, S, E);
}

DI void gemmA_in(PR p, LAS unsigned char* lds, int j, int c) {
    EpiU<0> E; E.Z2 = nullptr; E.U = (bf16_t*)(p.ws + OFF_UA); E.Z = (bf16_t*)(p.ws + OFF_ZA) + (size_t)c * 8192 * 1024; E.rope = (const float*)(p.ws + OFF_ROPE);
    run_gemm(p, lds, (const bf16_t*)(p.ws + OFF_XB) + (size_t)c * 8192 * 1024, (const bf16_t*)(p.ws + OFF_WAIN) + (size_t)j * 10240 * 1024, 8192, 10240, 1024, 1024, 0, E);
}
DI void gemm_out(PR p, LAS unsigned char* lds, const bf16_t* Y, const bf16_t* Wt, int K, bool first) {
    EpiRes E; E.xin = first ? p.x : p.out; E.xout = p.out;
    run_gemm(p, lds, Y, Wt, 32768, 1024, K, K, 0, E);
}

DI void layerA_phase(PR p, LAS unsigned char* lds, int s, int j, int li) {
    if (s <= 8) {
        if ((s & 1) == 0) {
            const int c = s >> 1;
            if (c > 0) mergeA_phase(p, (c - 1) * 8192);
            if (c < 4) gemmA_in(p, lds, j, c);
        } else {
            const int c = BID();
            if (NBLK() == 256) { for (int k = 0; k < 3; ++k) attnA_unit(lds, k * 256 + (((c & 7) << 5) | (c >> 3)), (const bf16_t*)(p.ws + OFF_UA), (bf16_t*)(p.ws + OFF_OG), (float*)(p.ws + OFF_LSE)); }
            else for (int u = c; u < 768; u += NBLK()) attnA_unit(lds, u, (const bf16_t*)(p.ws + OFF_UA), (bf16_t*)(p.ws + OFF_OG), (float*)(p.ws + OFF_LSE));
        }
    } else if (s == 9) {
        gemm_out(p, lds, (const bf16_t*)(p.ws + OFF_XB), (const bf16_t*)(p.ws + OFF_WAOUT) + (size_t)j * 1024 * 1024, 1024, li == 0);
    } else {
        if (li == 3) norm_phase<true>(p, p.out, p.final_g, nullptr, p.out);
        else norm_phase<false>(p, p.out, p.norm_g + (li + 1) * 1024, (bf16_t*)(p.ws + OFF_XB), nullptr);
    }
}
DI void bunit(int u, int& b, int& g, int& cur) {
    const int k = u >> 8, c = u & 255, x = c >> 5, bg = c & 31;
    const int base = 31 - 8 * k; cur = (k & 1) ? base - 7 + x : base - x; b = bg >> 1; g = bg & 1;
}
DI void layerB_phase(PR p, LAS unsigned char* lds, int s) {
    bf16_t* UB = (bf16_t*)(p.ws + OFF_UB); bf16_t* Y = (bf16_t*)(p.ws + OFF_XB);
    if (s == 0) {
        { const int tid = TID(), nb = NBLK(); const float* bp = (const float*)(p.ws + OFF_BPART); LAS float* red = (LAS float*)lds;
          for (int o = BID(); o < 256; o += nb) {
              float a = 0.f;
              for (int w = tid; w < nb; w += 512) a += bp[(size_t)w * 256 + o];
              a = wave_sum(a);
              __syncthreads();
              if ((tid & 63) == 0) red[tid >> 6] = a;
              __syncthreads();
              if (tid == 0) ((float*)(p.ws + OFF_BIAS1))[o] = red[0] + red[1] + red[2] + red[3] + red[4] + red[5] + red[6] + red[7];
          }
          __syncthreads(); }
        EpiU<1> E; E.U = UB; E.Z = (bf16_t*)(p.ws + OFF_KVC); E.Z2 = (bf16_t*)(p.ws + OFF_UBZ); E.rope = (const float*)(p.ws + OFF_ROPE);
        run_gemm(p, lds, (const bf16_t*)(p.ws + OFF_XB), (const bf16_t*)(p.ws + OFF_WBIN), 32768, 3840, 1024, 1024, 0, E);
    } else if (s == 1) {
        if (BID() < 32) { EpiCmp1 E; E.H = (bf16_t*)(p.ws + OFF_HB); E.bias = (const float*)(p.ws + OFF_BIAS1);
            pg8::Gemm g; g.A = (const bf16_t*)(p.ws + OFF_KVC); g.Bt = (const bf16_t*)(p.ws + OFF_WCMP1); g.M = 8192; g.N = 256; g.K = 4096; g.lda = 2048; g.apn = 0;
            pg8::StaticOrder S; S.init(8192, 256, 32, BID());
            pg8::gemm_phase<EpiCmp1>(lds, g, S, E); }
        unsigned* ctr = (unsigned*)(p.ws + OFF_BAR + XCD_BAR_BYTES);
        volatile LAS unsigned* stq = (volatile LAS unsigned*)(lds + LDS_WORK + 8);
        for (;;) {
            __syncthreads();
            if (TID() == 0) stq[0] = __hip_atomic_fetch_add(ctr, 1u, __ATOMIC_RELAXED, __HIP_MEMORY_SCOPE_AGENT);
            __syncthreads();
            const unsigned u = stq[0];
            if (u >= 1024u) break;
            int b, g, cur; bunit((int)u, b, g, cur); attnB_unit<0>(lds, b, g, cur, UB, nullptr, p.b_gate_b, Y);
        }
    } else if (s == 2) {
        EpiCmp2 E; E.KC = (bf16_t*)(p.ws + OFF_KC); E.VC = (bf16_t*)(p.ws + OFF_VC);
        run_gemm(p, lds, (const bf16_t*)(p.ws + OFF_HB), (const bf16_t*)(p.ws + OFF_WCMP2), 8192, 256, 256, 256, 0, E);
    } else if (s == 3) {
        for (int u = BID(); u < 1024; u += NBLK()) { int b, g, cur; bunit(u, b, g, cur);
            attnCmp_unit(lds, b, g, cur, UB, (const bf16_t*)(p.ws + OFF_KC), (const bf16_t*)(p.ws + OFF_VC), p.b_gate_b, Y, (unsigned*)(p.ws + OFF_SELM)); }
    } else if (s == 4) {
        for (int u = BID(); u < 1024; u += NBLK()) { int b, g, cur; bunit(u, b, g, cur); attnB_unit<1>(lds, b, g, cur, UB, (const unsigned*)(p.ws + OFF_SELM), p.b_gate_b, Y); }
    } else if (s == 5) {
        gemm_out(p, lds, Y, (const bf16_t*)(p.ws + OFF_WBOUT), 1024, false);
    } else {
        norm_phase<false>(p, p.out, p.norm_g + 2 * 1024, (bf16_t*)(p.ws + OFF_XB), nullptr);
    }
}
DI void layerC_phase(PR p, LAS unsigned char* lds, int s) {
    if (s == 0) {
        EpiU<2> E; E.Z2 = nullptr; E.U = (bf16_t*)(p.ws + OFF_XRAW); E.Z = (bf16_t*)(p.ws + OFF_ZC); E.rope = nullptr;
        run_gemm(p, lds, (const bf16_t*)(p.ws + OFF_XB), (const bf16_t*)(p.ws + OFF_WCIN), 32768, 2560, 1024, 1024, 0, E);
    } else if (s == 1) gate_phase(p, lds);
    else if (s == 2) scan_phase<0>(p);
    else if (s == 3) scan_phase<1>(p);
    else if (s == 4) gemm_out(p, lds, (const bf16_t*)(p.ws + OFF_XRAW), (const bf16_t*)(p.ws + OFF_WCOUT), 1280, false);
    else norm_phase<false>(p, p.out, p.norm_g + 3 * 1024, (bf16_t*)(p.ws + OFF_XB), nullptr);
}

__global__ __launch_bounds__(512, 2) void mega_fwd(Params p_) {
    extern __shared__ __attribute__((aligned(16))) unsigned char shm[];
    LAS unsigned char* lds = (LAS unsigned char*)shm;
    volatile LAS unsigned* st = (volatile LAS unsigned*)(lds + LDS_WORK);
    if (threadIdx.x < 4) st[threadIdx.x] = 0u;
    __syncthreads();
    const XcdBarrier xb = xcd_barrier_post((unsigned*)(p_.ws + OFF_BAR), st);
    for (int ph = p_.ph_lo; ph < p_.ph_hi; ++ph) {
        const __attribute__((address_space(4))) Params* pp = (const __attribute__((address_space(4))) Params*)__builtin_amdgcn_kernarg_segment_ptr();
        asm volatile("" : "+s"(pp));
        PR p = *pp;
        if (ph == 0) prep_phase(p, lds);
        else if (ph >= PH_B && ph < PH_C) layerB_phase(p, lds, ph - PH_B);
        else if (ph >= PH_C && ph < PH_A1) layerC_phase(p, lds, ph - PH_C);
        else { const bool second = ph >= PH_A1;
            layerA_phase(p, lds, second ? ph - PH_A1 : ph - PH_A0, second ? 1 : 0, second ? 3 : 0); }
        if (p_.coop && ph + 1 < p_.ph_hi) {
            if (ph == 0) cg::this_grid().sync();
            else xcd_barrier(xb);
        }
    }
}

extern "C" void kernel_launch(void* const* d_in, const int* in_sizes, int n_in, void* d_out, int out_size, void* d_ws, size_t ws_size, hipStream_t stream) {
    static int grid = 0;
    if (grid == 0) {
        int dev = 0, cus = 0, per_cu = 0;
        hipGetDevice(&dev);
        hipDeviceGetAttribute(&cus, hipDeviceAttributeMultiprocessorCount, dev);
        hipFuncSetAttribute((const void*)mega_fwd, hipFuncAttributeMaxDynamicSharedMemorySize, LDS_BYTES);
        hipOccupancyMaxActiveBlocksPerMultiprocessor(&per_cu, (const void*)mega_fwd, 512, LDS_BYTES);
        if (per_cu < 1) per_cu = 1;
        grid = cus * per_cu;
        if (ws_size < WS_NEED) fprintf(stderr, "kernel_launch: workspace too small: %zu < %zu\n", ws_size, (size_t)WS_NEED);
    }
    Params p{};
    const float** f = (const float**)&p;
    for (int i = 0; i < 23; ++i) f[i] = (const float*)d_in[i];
    p.out = (float*)d_out; p.ws = (unsigned char*)d_ws;
    p.ph_lo = 0; p.ph_hi = PH_END; p.coop = 1; p.pad = 0;
    hipMemsetAsync((unsigned char*)d_ws + OFF_BAR, 0, XCD_BAR_BYTES + 256, stream);
    void* args[] = {&p};
    hipError_t e = hipLaunchCooperativeKernel((const void*)mega_fwd, dim3(grid), dim3(512), args, LDS_BYTES, stream);
    if (e != hipSuccess) fprintf(stderr, "cooperative launch failed: %s (grid %d)\n", hipGetErrorString(e), grid);
}
```

```cpp
#include <hip/hip_runtime.h>
#include <hip/hip_cooperative_groups.h>
#include <cstdio>
namespace cg = cooperative_groups;

typedef unsigned short bf16_t;
typedef short bf16x8 __attribute__((ext_vector_type(8)));
typedef short s16x4 __attribute__((ext_vector_type(4)));
typedef float f32x2 __attribute__((ext_vector_type(2)));
typedef float f32x4 __attribute__((ext_vector_type(4)));
typedef float f32x16 __attribute__((ext_vector_type(16)));
typedef unsigned u32x2 __attribute__((ext_vector_type(2)));
typedef unsigned u32x4 __attribute__((ext_vector_type(4)));
typedef __bf16 bf2_t __attribute__((ext_vector_type(2)));
#define LAS __attribute__((address_space(3)))
#define DI __device__ __forceinline__

DI unsigned pk2(float lo, float hi) { f32x2 v = {lo, hi}; bf2_t b = __builtin_convertvector(v, bf2_t); return __builtin_bit_cast(unsigned, b); }
DI float bflo(unsigned u) { return __uint_as_float(u << 16); }
DI float bfhi(unsigned u) { return __uint_as_float(u & 0xffff0000u); }
DI float bf2f(bf16_t b) { return __uint_as_float(((unsigned)b) << 16); }
DI float sigm(float x) { return 1.f / (1.f + __expf(-x)); }
DI float silu(float x) { return x / (1.f + __expf(-x)); }
DI void st16_wt(void* p, u32x4 v) { asm volatile("global_store_dwordx4 %0, %1, off sc1\n\ts_nop 1" :: "v"(p), "v"(v) : "memory"); }
DI void st8_wt(void* p, u32x2 v) { asm volatile("global_store_dwordx2 %0, %1, off sc1\n\ts_nop 1" :: "v"(p), "v"(v) : "memory"); }
DI void st16f_wt(float* p, f32x4 v) { asm volatile("global_store_dwordx4 %0, %1, off sc1\n\ts_nop 1" :: "v"(p), "v"(v) : "memory"); }
DI int BID() { int t = blockIdx.x; asm volatile("" : "+s"(t)); return t; }
DI int NBLK() { int t = gridDim.x; asm volatile("" : "+s"(t)); return t; }
DI int TID() { int t = threadIdx.x; asm volatile("" : "+v"(t)); return t; }

constexpr size_t XCD_BAR_BYTES = 3456 * 4;
constexpr size_t OFF_WAIN = 0;
constexpr size_t OFF_WAOUT = OFF_WAIN + 2ull * 10240 * 1024 * 2;
constexpr size_t OFF_WBIN = OFF_WAOUT + 2ull * 1024 * 1024 * 2;
constexpr size_t OFF_WBOUT = OFF_WBIN + 3840ull * 1024 * 2;
constexpr size_t OFF_WCIN = OFF_WBOUT + 1024ull * 1024 * 2;
constexpr size_t OFF_WCOUT = OFF_WCIN + 2560ull * 1024 * 2;
constexpr size_t OFF_WCMP1 = OFF_WCOUT + 1024ull * 1280 * 2;
constexpr size_t OFF_WCMP2 = OFF_WCMP1 + 256ull * 4096 * 2;
constexpr size_t OFF_WGATE = OFF_WCMP2 + 256ull * 256 * 2;
constexpr size_t OFF_ROPE = OFF_WGATE + 10ull * 256 * 128 * 2;
constexpr size_t OFF_BIAS1 = OFF_ROPE + 2048ull * 32 * 4;
constexpr size_t OFF_SP8 = OFF_BIAS1 + 1024;
constexpr size_t OFF_XB = OFF_BIAS1 + 8192;
constexpr size_t OFF_R = OFF_XB + 32768ull * 1024 * 2;
constexpr size_t OFF_UA = OFF_R;
constexpr size_t OFF_ZA = OFF_UA + 8192ull * 9216 * 2;
constexpr size_t OFF_OG = OFF_ZA + 32768ull * 1024 * 2;
constexpr size_t OFF_LSE = OFF_OG + 3ull * 8192 * 1024 * 2;
constexpr size_t OFF_UB = OFF_R;
constexpr size_t OFF_UBZ = OFF_UB + 16ull * 32768 * 128 * 2;
constexpr size_t OFF_KVC = OFF_UBZ + 32768ull * 1056 * 2;
constexpr size_t OFF_HB = OFF_KVC + 2ull * 16 * 2 * 2048 * 128 * 2 + 8192;
constexpr size_t OFF_KC = OFF_HB + 8192ull * 256 * 2;
constexpr size_t OFF_VC = OFF_KC + 4096ull * 128 * 2;
constexpr size_t OFF_SELM = OFF_VC + 4096ull * 128 * 2;
constexpr size_t OFF_AB = OFF_XB;
constexpr size_t OFF_XRAW = OFF_AB + 32768ull * 1280 * 4;
constexpr size_t OFF_ZC = OFF_XRAW + 32768ull * 1280 * 2;
constexpr size_t OFF_XC = OFF_ZC + 32768ull * 1280 * 2;
constexpr size_t OFF_CARRY = OFF_XC + 32768ull * 1280 * 2;
constexpr size_t OFF_BPART = OFF_CARRY + 16ull * 32 * 1280 * 8;
constexpr size_t OFF_BAR = OFF_BPART + 1024ull * 256 * 4;
constexpr size_t WS_NEED = OFF_BAR + XCD_BAR_BYTES + 256;

struct Params {
    const float *x, *norm_g, *final_g, *a_w_in, *a_w_out, *b_w_in, *b_gate_b, *b_pe_k, *b_w1_k, *b_w2_k, *b_pe_v, *b_w1_v, *b_w2_v, *b_w_out,
        *c_w_in, *c_conv_w, *c_conv_b, *c_wa, *c_ba, *c_wx, *c_bx, *c_lambda, *c_w_out;
    float* out; unsigned char* ws;
    int ph_lo, ph_hi, coop, pad;
};
typedef const __attribute__((address_space(4))) Params& PR;

namespace pg8 {
constexpr int BM = 256, BK = 64, HALF = 128, HTB = HALF * BK * 2, STAGE_BYTES = 8 * HTB, NXCD = 8, WGM = 4;
DI int lds_byte(int r, int c) { const int st = (r >> 4) * 2 + (c >> 5), rr = r & 15, cc = c & 31, ob = rr * 64 + cc * 2; return st * 1024 + (ob ^ (((ob >> 9) & 1) << 5)); }
DI void stage_rc(int b, int& R, int& C) { const int st = b / 1024, sb = b % 1024, swz = sb ^ (((sb >> 9) & 1) << 5); R = (st >> 1) * 16 + swz / 64; C = (st & 1) * 32 + (swz % 64) / 2; }
DI int perm32(int rho) { const int n = rho >> 4, i = rho & 15; return 8 * (i >> 2) + 4 * n + (i & 3); }
struct Unit { int pm, pn; };
struct Gemm { const bf16_t* A; const bf16_t* Bt; int M, N, K, lda; int apn; };
struct StaticOrder {
    int nM, nN, nwg, G, c;
    DI void init(int M, int N, int G_, int c_) { nM = M / BM; nN = N / BM; nwg = nM * nN; G = G_; c = c_; }
    DI bool next(int i, Unit& u) const {
        const long L = (long)i * G + c; if (L >= nwg) return false;
        int wgid = (int)L; { const int q = nwg / NXCD, r = nwg % NXCD, xcd = wgid % NXCD, off = wgid / NXCD; wgid = (xcd < r ? xcd * (q + 1) : r * (q + 1) + (xcd - r) * q) + off; }
        const int nig = WGM * nN, gid = wgid / nig, fm = gid * WGM, gsz = (nM - fm) < WGM ? (nM - fm) : WGM;
        u.pm = fm + ((wgid % nig) % gsz); u.pn = (wgid % nig) / gsz; return true;
    }
};

template <class Epi>
DI void gemm_phase(LAS unsigned char* lds, const Gemm g, const StaticOrder& S, const Epi& E) {
    const int tid = TID(), wid = __builtin_amdgcn_readfirstlane(tid >> 6), lane = tid & 63, wr = wid >> 2, wc = wid & 3, fr = lane & 15, fq = lane >> 4;
    const int K = g.K, nt = K / BK;
    unsigned voffA[2], voffB[2];
#pragma unroll
    for (int i = 0; i < 2; ++i) { int R, C; stage_rc(tid * 16 + i * 8192, R, C); const int Rb = Epi::PERM ? ((R & ~31) + perm32(R & 31)) : R;
        voffA[i] = (unsigned)(R * g.lda + C) * 2u; voffB[i] = (unsigned)(Rb * K + C) * 2u; }
    const size_t kstep = (size_t)(BK * 2);
    const size_t hstepA = (size_t)HALF * g.lda * 2, hstepB = (size_t)HALF * K * 2;
    const size_t tstepA = 2 * hstepA, tstepB = 2 * hstepB;
    const unsigned ldsw = (unsigned)wid * 1024u;
    const int aoff = lds_byte(wr * 64 + fr, fq * 8), boff = lds_byte(wc * 32 + fr, fq * 8);
#define PG8_SA(b, h) (((b) * 2 + (h)) * HTB)
#define PG8_SB(b, h) ((4 + (b) * 2 + (h)) * HTB)
#define PG8_STAGE(bufoff, gbase, voff) do { _Pragma("unroll") for (int _i = 0; _i < 2; ++_i) { unsigned _vo = (voff)[_i]; asm volatile("" : "+v"(_vo)); \
        __builtin_amdgcn_global_load_lds((const unsigned*)((const char*)(gbase) + _vo), (LAS unsigned*)(lds + (bufoff) + ldsw + _i * 8192), 16, 0, 0); } } while (0)
#define PG8_LDA(dst, b, h) do { _Pragma("unroll") for (int m = 0; m < 4; ++m) _Pragma("unroll") for (int k = 0; k < 2; ++k) dst[m][k] = *(const LAS bf16x8*)(lds + PG8_SA(b, h) + aoff + m * 2048 + k * 1024); } while (0)
#define PG8_LDB(dst, b, h) do { _Pragma("unroll") for (int n = 0; n < 2; ++n) _Pragma("unroll") for (int k = 0; k < 2; ++k) dst[n][k] = *(const LAS bf16x8*)(lds + PG8_SB(b, h) + boff + n * 2048 + k * 1024); } while (0)
#define PG8_MMA(ai, bj, At, Bt) do { __builtin_amdgcn_s_setprio(1); _Pragma("unroll") for (int m = 0; m < 4; ++m) _Pragma("unroll") for (int n = 0; n < 2; ++n) _Pragma("unroll") for (int k = 0; k < 2; ++k) \
        acc[ai][bj][m][n] = __builtin_amdgcn_mfma_f32_16x16x32_bf16(Bt[n][k], At[m][k], acc[ai][bj][m][n], 0, 0, 0); __builtin_amdgcn_s_setprio(0); } while (0)
#define PG8_WAIT_V(n) asm volatile("s_waitcnt vmcnt(" #n ")" ::: "memory")
#define PG8_WAIT_L(n) asm volatile("s_waitcnt lgkmcnt(" #n ")" ::: "memory")
#define PG8_BAR __builtin_amdgcn_s_barrier()
#define PG8_SCHED __builtin_amdgcn_sched_barrier(0)
    Unit cur, nxt; int ui = 0;
    if (!S.next(0, cur)) return;
    f32x4 acc[2][2][4][2];
#pragma unroll
    for (int a = 0; a < 2; ++a)
#pragma unroll
        for (int b = 0; b < 2; ++b)
#pragma unroll
            for (int m = 0; m < 4; ++m)
#pragma unroll
                for (int n = 0; n < 2; ++n) acc[a][b][m][n] = (f32x4){0.f, 0.f, 0.f, 0.f};
    bf16x8 At[4][2], B0[2][2], B1[2][2];
    const char* cA = (const char*)g.A + (size_t)cur.pm * tstepA + (size_t)cur.pn * g.apn; const char* cB = (const char*)g.Bt + (size_t)cur.pn * tstepB;
    PG8_STAGE(PG8_SB(0, 0), cB, voffB); PG8_STAGE(PG8_SA(0, 0), cA, voffA); PG8_STAGE(PG8_SB(0, 1), cB + hstepB, voffB); PG8_STAGE(PG8_SA(0, 1), cA + hstepA, voffA);
    if (wr == 1) PG8_BAR;
    PG8_WAIT_V(4); PG8_BAR;
    PG8_STAGE(PG8_SB(1, 0), cB + kstep, voffB); PG8_STAGE(PG8_SA(1, 0), cA + kstep, voffA); PG8_STAGE(PG8_SB(1, 1), cB + hstepB + kstep, voffB);
    PG8_WAIT_V(6); PG8_BAR;
    for (;;) {
        const bool has_next = S.next(ui + 1, nxt);
        const char* nA = has_next ? (const char*)g.A + (size_t)nxt.pm * tstepA + (size_t)nxt.pn * g.apn : cA; const char* nB = has_next ? (const char*)g.Bt + (size_t)nxt.pn * tstepB : cB;
        for (int t = 0; t < nt; t += 2) {
            const bool last = (t == nt - 2);
            const char* a1 = cA + (size_t)(t + 1) * kstep;
            const char* a2 = last ? nA : cA + (size_t)(t + 2) * kstep; const char* b2 = last ? nB : cB + (size_t)(t + 2) * kstep;
            const char* a3 = a2 + kstep; const char* b3 = b2 + kstep;
            PG8_LDB(B0, 0, 0); PG8_SCHED; PG8_LDA(At, 0, 0); PG8_STAGE(PG8_SA(1, 1), a1 + hstepA, voffA);
            PG8_WAIT_L(8); PG8_BAR; PG8_WAIT_L(0); PG8_MMA(0, 0, At, B0); PG8_BAR; PG8_SCHED;
            PG8_LDB(B1, 0, 1); PG8_STAGE(PG8_SB(0, 0), b2, voffB);
            PG8_BAR; PG8_WAIT_L(0); PG8_MMA(0, 1, At, B1); PG8_BAR;
            PG8_LDA(At, 0, 1); PG8_STAGE(PG8_SA(0, 0), a2, voffA);
            PG8_BAR; PG8_WAIT_L(0); PG8_MMA(1, 0, At, B0); PG8_BAR; PG8_SCHED;
            PG8_STAGE(PG8_SB(0, 1), b2 + hstepB, voffB);
            PG8_WAIT_V(6); PG8_BAR; PG8_MMA(1, 1, At, B1); PG8_BAR;
            PG8_LDB(B0, 1, 0); PG8_SCHED; PG8_LDA(At, 1, 0); PG8_STAGE(PG8_SA(0, 1), a2 + hstepA, voffA);
            PG8_WAIT_L(8); PG8_BAR; PG8_WAIT_L(0); PG8_MMA(0, 0, At, B0); PG8_BAR; PG8_SCHED;
            PG8_LDB(B1, 1, 1); PG8_STAGE(PG8_SB(1, 0), b3, voffB);
            PG8_BAR; PG8_WAIT_L(0); PG8_MMA(0, 1, At, B1); PG8_BAR;
            PG8_LDA(At, 1, 1); PG8_STAGE(PG8_SA(1, 0), a3, voffA);
            PG8_BAR; PG8_WAIT_L(0); PG8_MMA(1, 0, At, B0); PG8_BAR; PG8_SCHED;
            PG8_STAGE(PG8_SB(1, 1), b3 + hstepB, voffB);
            PG8_WAIT_V(6); PG8_BAR; PG8_MMA(1, 1, At, B1); PG8_BAR;
        }
        E(acc, cur, wr, wc, fr, fq);
        if (!has_next) break;
#pragma unroll
        for (int a = 0; a < 2; ++a)
#pragma unroll
            for (int b = 0; b < 2; ++b)
#pragma unroll
                for (int m = 0; m < 4; ++m)
#pragma unroll
                    for (int n = 0; n < 2; ++n) acc[a][b][m][n] = (f32x4){0.f, 0.f, 0.f, 0.f};
        cur = nxt; cA = nA; cB = nB; ++ui;
    }
    PG8_WAIT_V(0);
    if (wr == 0) PG8_BAR;
    PG8_BAR;
#undef PG8_SA
#undef PG8_SB
#undef PG8_STAGE
#undef PG8_LDA
#undef PG8_LDB
#undef PG8_MMA
#undef PG8_WAIT_V
#undef PG8_WAIT_L
#undef PG8_BAR
#undef PG8_SCHED
}
}
using pg8::Unit;

template <int KIND> struct EpiU {
    static constexpr bool PERM = true;
    bf16_t* U; bf16_t* Z; bf16_t* Z2; const float* rope;
    DI void operator()(const f32x4 (&acc)[2][2][4][2], const Unit& u, int wr, int wc, int fr, int fq) const {
        const int rowb = u.pm * 256 + wr * 64 + fr;
#pragma unroll
        for (int bj = 0; bj < 2; ++bj) {
            const int hh = 2 * u.pn + bj;
            const int col = u.pn * 256 + bj * 128 + wc * 32 + 8 * fq;
            bool dorope = false, ropep = false, store = true, cmp = false; bf16_t* dst = U; long ld = 0, cofs = 0; int which = 0, gg = 0;
            if (KIND == 0) { ropep = hh < 72 && ((hh % 24) < 16); if (hh < 72) { dst = U + (size_t)hh * 8192 * 128; ld = 128; cofs = col & 127; } else { dst = Z; ld = 1024; cofs = col - 9216; } }
            if (KIND == 1) { dorope = (hh == 8 || hh == 9); ropep = hh < 8 || hh == 12 || hh == 13 || hh == 16 || hh == 17;
                if (hh >= 8 && hh < 12) { cmp = true; which = (hh - 8) >> 1; gg = (hh - 8) & 1; dst = Z; }
                else if (hh < 20) { dst = U + (size_t)(hh < 8 ? hh : hh - 4) * 32768 * 128; ld = 128; cofs = col & 127; }
                else { dst = Z2; ld = 1056; cofs = col - 2560; store = (cofs + 8 <= 1056); } }
            if (KIND == 2) { if (hh < 10) { dst = U; ld = 1280; cofs = col; } else { dst = Z; ld = 1280; cofs = col - 1280; } }
            const bool rp = dorope && (wc == 0);
            const float sg = (fq < 2) ? -1.f : 1.f;
#pragma unroll
            for (int ai = 0; ai < 2; ++ai) {
                f32x4 cq[4], sq[4];
                if (ropep && fq == 0) {
#pragma unroll
                    for (int m = 0; m < 4; ++m) { const float* cs = rope + ((rowb + ai * 128 + m * 16) & 2047) * 32 + 4 * wc; cq[m] = *(const f32x4*)cs; sq[m] = *(const f32x4*)(cs + 16); }
                }
                asm volatile("" ::: "memory");
#pragma unroll
                for (int m = 0; m < 4; ++m) {
                    const int row = rowb + ai * 128 + m * 16;
                    f32x4 v0 = acc[ai][bj][m][0], v1 = acc[ai][bj][m][1];
                    if (ropep) {
                        if (fq == 0) { const f32x4 c = cq[m], s = sq[m];
                            const f32x4 n0 = v0 * c - v1 * s, n1 = v1 * c + v0 * s; v0 = n0; v1 = n1; }
                    } else if (rp) {
                        const float* cs = rope + (row & 2047) * 32 + 8 * (fq & 1);
                        const f32x4 c0 = *(const f32x4*)cs, c1 = *(const f32x4*)(cs + 4), s0 = *(const f32x4*)(cs + 16), s1 = *(const f32x4*)(cs + 20);
                        f32x4 p0, p1;
#pragma unroll
                        for (int e = 0; e < 4; ++e) { p0[e] = __shfl_xor(v0[e], 32); p1[e] = __shfl_xor(v1[e], 32); }
                        v0 = v0 * c0 + sg * (p0 * s0); v1 = v1 * c1 + sg * (p1 * s1);
                    }
                    u32x4 w; w[0] = pk2(v0[0], v0[1]); w[1] = pk2(v0[2], v0[3]); w[2] = pk2(v1[0], v1[1]); w[3] = pk2(v1[2], v1[3]);
                    if (cmp) { const int b = row >> 11, t = row & 2047; *(u32x4*)(dst + ((((size_t)which * 16 + b) * 2 + gg) * 2048 + t) * 128 + (col & 127)) = w; }
                    else if (store) *(u32x4*)(dst + (size_t)row * ld + cofs) = w;
                }
            }
        }
    }
};
struct EpiRes {
    static constexpr bool PERM = false;
    const float* xin; float* xout;
    DI void operator()(const f32x4 (&acc)[2][2][4][2], const Unit& u, int wr, int wc, int fr, int fq) const {
        const int row0 = u.pm * 256 + wr * 64 + fr, col0 = u.pn * 256 + wc * 32 + 4 * fq;
#pragma unroll
        for (int ai = 0; ai < 2; ++ai) {
            f32x4 xr[4][2][2];
#pragma unroll
            for (int m = 0; m < 4; ++m) { const size_t off = (size_t)(row0 + ai * 128 + m * 16) * 1024 + col0;
#pragma unroll
                for (int bj = 0; bj < 2; ++bj)
#pragma unroll
                    for (int n = 0; n < 2; ++n) xr[m][bj][n] = *(const f32x4*)(xin + off + bj * 128 + n * 16); }
            asm volatile("" ::: "memory");
#pragma unroll
            for (int m = 0; m < 4; ++m) { const size_t off = (size_t)(row0 + ai * 128 + m * 16) * 1024 + col0;
#pragma unroll
                for (int bj = 0; bj < 2; ++bj)
#pragma unroll
                    for (int n = 0; n < 2; ++n) *(f32x4*)(xout + off + bj * 128 + n * 16) = xr[m][bj][n] + acc[ai][bj][m][n]; }
            asm volatile("" ::: "memory");
        }
    }
};
struct EpiCmp1 {
    static constexpr bool PERM = true;
    bf16_t* H; const float* bias;
    DI void operator()(const f32x4 (&acc)[2][2][4][2], const Unit& u, int wr, int wc, int fr, int fq) const {
        const int rowb = u.pm * 256 + wr * 64 + fr; const int sel = (u.pm >= 16) ? 1 : 0;
#pragma unroll
        for (int bj = 0; bj < 2; ++bj) {
            const int col = bj * 128 + wc * 32 + 8 * fq;
            const f32x4 b0 = *(const f32x4*)(bias + col), b1 = *(const f32x4*)(bias + col + 4);
#pragma unroll
            for (int ai = 0; ai < 2; ++ai)
#pragma unroll
                for (int m = 0; m < 4; ++m) {
                    const int row = rowb + ai * 128 + m * 16;
                    u32x4 w = {0u, 0u, 0u, 0u};
                    if (bj == sel) { f32x4 v0 = acc[ai][bj][m][0] + b0, v1 = acc[ai][bj][m][1] + b1;
                        w[0] = pk2(silu(v0[0]), silu(v0[1])); w[1] = pk2(silu(v0[2]), silu(v0[3])); w[2] = pk2(silu(v1[0]), silu(v1[1])); w[3] = pk2(silu(v1[2]), silu(v1[3])); }
                    *(u32x4*)(H + (size_t)row * 256 + col) = w;
                }
        }
    }
};
struct EpiCmp2 {
    static constexpr bool PERM = true;
    bf16_t* KC; bf16_t* VC;
    DI void operator()(const f32x4 (&acc)[2][2][4][2], const Unit& u, int wr, int wc, int fr, int fq) const {
        const int rowb = u.pm * 256 + wr * 64 + fr; const bool sel = (u.pm >= 16);
        bf16_t* dst0 = (sel ? VC + (size_t)(rowb - 4096) * 128 : KC + (size_t)rowb * 128) + wc * 32 + 8 * fq;
#pragma unroll
        for (int ai = 0; ai < 2; ++ai)
#pragma unroll
            for (int m = 0; m < 4; ++m) {
                const int row = rowb + ai * 128 + m * 16;
                const f32x4 v0 = sel ? acc[ai][1][m][0] : acc[ai][0][m][0], v1 = sel ? acc[ai][1][m][1] : acc[ai][0][m][1];
                u32x4 w; w[0] = pk2(v0[0], v0[1]); w[1] = pk2(v0[2], v0[3]); w[2] = pk2(v1[0], v1[1]); w[3] = pk2(v1[2], v1[3]);
                if ((row & 127) == 127) w = (u32x4){0u, 0u, 0u, 0u};
                *(u32x4*)(dst0 + (size_t)(ai * 128 + m * 16) * 128) = w;
            }
    }
};
constexpr int KT_P = 272, VT_P = 320, KT_B = 64 * KT_P, VT_B = 64 * VT_P, HB_B = KT_B + VT_B;
constexpr int LDS_WORK = 4 * HB_B;
constexpr int LDS_BYTES = LDS_WORK + 16;
#define MFMA32(a, b, c) __builtin_amdgcn_mfma_f32_32x32x16_bf16((a), (b), (c), 0, 0, 0)
DI s16x4 trrd(LAS const unsigned char* p) { return __builtin_amdgcn_ds_read_tr16_b64_v4i16((LAS s16x4*)p); }
DI bf16x8 pack8(const f32x16& x, int s) {
    u32x4 p; p[0] = pk2(x[8 * s], x[8 * s + 1]); p[1] = pk2(x[8 * s + 2], x[8 * s + 3]); p[2] = pk2(x[8 * s + 4], x[8 * s + 5]); p[3] = pk2(x[8 * s + 6], x[8 * s + 7]);
    return __builtin_bit_cast(bf16x8, p);
}
struct AttnW { const bf16_t *q, *k, *v; long qs, kvs; int mq0, maxd; unsigned need; };
constexpr float SCL = 0.08838834764831845f * 1.4426950408889634f;

constexpr int HB2 = 32768;
template <int MODE, bool SHARED>
DI void attn_core(LAS unsigned char* lds, const AttnW& w, unsigned selm, int ntrip, f32x16 (&o)[4], float& m_run, float& l_run) {
    const int tid = TID(), lane = tid & 63, r = lane & 31, h = lane >> 5, half = tid >> 8, hl = tid & 255;
    const int wvh = SHARED ? (tid >> 6) : (hl >> 6);
    LAS unsigned char* hb = SHARED ? lds : lds + half * 2 * HB2;
    const int rl = wvh * 4 + (lane >> 4);
    const long koff = (long)rl * w.kvs + (((lane & 15) ^ (rl & 15)) * 8);
    const long voff = (long)rl * w.kvs + (((lane & 15) ^ ((rl & 3) << 2)) * 8);
    auto dma = [&](int tile, int b) {
        const bf16_t* kp = w.k + (long)tile * 64 * w.kvs + koff; const bf16_t* vp = w.v + (long)tile * 64 * w.kvs + voff;
        LAS unsigned char* dst = hb + b * HB2 + wvh * 1024;
        constexpr int NI = SHARED ? 2 : 4, RS = SHARED ? 32 : 16, DS = SHARED ? 8192 : 4096;
#pragma unroll
        for (int i = 0; i < NI; ++i) {
            __builtin_amdgcn_global_load_lds((const unsigned*)(kp + (long)(RS * i) * w.kvs), (LAS unsigned*)(dst + i * DS), 16, 0, 0);
            __builtin_amdgcn_global_load_lds((const unsigned*)(vp + (long)(RS * i) * w.kvs), (LAS unsigned*)(dst + 16384 + i * DS), 16, 0, 0);
        }
    };
    unsigned rem = __builtin_amdgcn_readfirstlane(w.need);
    int tcur = -1;
    if (rem) { tcur = __builtin_ctz(rem); rem &= rem - 1; }
    if (tcur >= 0) dma(tcur, 0);
    bf16x8 qf[8];
    { const bf16_t* qp = w.q + (long)r * w.qs + h * 8;
#pragma unroll
      for (int ks = 0; ks < 8; ++ks) qf[ks] = *(const bf16x8*)(qp + ks * 16); }
#pragma unroll
    for (int db = 0; db < 4; ++db)
#pragma unroll
        for (int i = 0; i < 16; ++i) o[db][i] = 0.f;
    m_run = -INFINITY; l_run = 0.f;
    const int mrow = w.mq0 + r;
    const int i16 = lane & 15, q4 = i16 >> 2, pp = i16 & 3, blk = (lane >> 4) & 1;
    const unsigned kaoff = (unsigned)(r * 256 + (((r & 15) ^ h) << 4));
    const unsigned vaoff = (unsigned)((4 * h + q4) * 256 + (q4 << 6) + blk * 32 + pp * 8);
    asm volatile("s_waitcnt vmcnt(0)" ::: "memory");
    __syncthreads();
    for (int it = 0; it < ntrip; ++it) {
        int tnext = -1;
        if (rem) { tnext = __builtin_ctz(rem); rem &= rem - 1; }
        if (tnext >= 0) dma(tnext, (it + 1) & 1);
        const unsigned Kt = (unsigned)(size_t)(hb + (it & 1) * HB2), Vt = Kt + 16384u;
        const int ts = tcur * 64;
        const bool act = (tcur >= 0) && !((MODE == 0) && (ts > w.mq0 + 31 || ts + 63 < w.mq0 - w.maxd));
        if (act) {
            f32x16 s0, s1;
#pragma unroll
            for (int i = 0; i < 16; ++i) { s0[i] = 0.f; s1[i] = 0.f; }
            const unsigned ka = Kt + kaoff;
#pragma unroll
            for (int ks = 0; ks < 8; ++ks) {
                const bf16x8 a0 = *(LAS const bf16x8*)(size_t)(ka ^ (unsigned)(ks * 32)), a1 = *(LAS const bf16x8*)(size_t)((ka ^ (unsigned)(ks * 32)) + 8192u);
                s0 = MFMA32(a0, qf[ks], s0); s1 = MFMA32(a1, qf[ks], s1);
            }
            const bool full = (MODE == 0) && (ts + 63 <= w.mq0) && (w.mq0 + 31 - ts <= w.maxd);
            float mx = -INFINITY;
            if (full) {
#pragma unroll
                for (int i = 0; i < 16; ++i) { s0[i] *= SCL; s1[i] *= SCL; mx = fmaxf(mx, fmaxf(s0[i], s1[i])); }
            } else {
                const int d0 = mrow - ts - 4 * h; const int dl = d0 - w.maxd;
                const bool lok = (MODE == 1) ? (((selm >> tcur) & 1u) != 0u) : true;
#pragma unroll
                for (int i = 0; i < 16; ++i) {
                    const int ci = (i & 3) + 8 * (i >> 2);
                    const bool v0 = lok && (ci <= d0) && (ci >= dl), v1 = lok && (ci + 32 <= d0) && (ci + 32 >= dl);
                    s0[i] = v0 ? s0[i] * SCL : -INFINITY; s1[i] = v1 ? s1[i] * SCL : -INFINITY;
                    mx = fmaxf(mx, fmaxf(s0[i], s1[i]));
                }
            }
            mx = fmaxf(mx, __shfl_xor(mx, 32));
            const float m_new = fmaxf(m_run, mx); const float m_use = (m_new == -INFINITY) ? 0.f : m_new;
            const float alpha = __builtin_amdgcn_exp2f(m_run - m_use);
            float ls = 0.f;
#pragma unroll
            for (int i = 0; i < 16; ++i) { s0[i] = __builtin_amdgcn_exp2f(s0[i] - m_use); s1[i] = __builtin_amdgcn_exp2f(s1[i] - m_use); ls += s0[i] + s1[i]; }
            ls += __shfl_xor(ls, 32);
            l_run = l_run * alpha + ls; m_run = m_new;
#pragma unroll
            for (int db = 0; db < 4; ++db)
#pragma unroll
                for (int i = 0; i < 16; ++i) o[db][i] *= alpha;
            const unsigned va = Vt + vaoff;
#pragma unroll
            for (int kb = 0; kb < 2; ++kb)
#pragma unroll
                for (int s2 = 0; s2 < 2; ++s2) {
                    const bf16x8 pf = pack8(kb ? s1 : s0, s2);
                    const unsigned vb = va + (unsigned)((kb * 32 + 16 * s2) * 256);
                    const unsigned a0 = vb, a1 = vb ^ 64u, a2 = vb ^ 128u, a3 = vb ^ 192u;
                    s16x4 l0, h0, l1, h1, l2, h2, l3, h3;
                    asm volatile("ds_read_b64_tr_b16 %0, %8\n\tds_read_b64_tr_b16 %1, %8 offset:2048\n\t"
                                 "ds_read_b64_tr_b16 %2, %9\n\tds_read_b64_tr_b16 %3, %9 offset:2048\n\t"
                                 "ds_read_b64_tr_b16 %4, %10\n\tds_read_b64_tr_b16 %5, %10 offset:2048\n\t"
                                 "ds_read_b64_tr_b16 %6, %11\n\tds_read_b64_tr_b16 %7, %11 offset:2048\n\t"
                                 "s_waitcnt lgkmcnt(0)"
                                 : "=&v"(l0), "=&v"(h0), "=&v"(l1), "=&v"(h1), "=&v"(l2), "=&v"(h2), "=&v"(l3), "=&v"(h3)
                                 : "v"(a0), "v"(a1), "v"(a2), "v"(a3) : "memory");
                    o[0] = MFMA32(__builtin_shufflevector(l0, h0, 0, 1, 2, 3, 4, 5, 6, 7), pf, o[0]);
                    o[1] = MFMA32(__builtin_shufflevector(l1, h1, 0, 1, 2, 3, 4, 5, 6, 7), pf, o[1]);
                    o[2] = MFMA32(__builtin_shufflevector(l2, h2, 0, 1, 2, 3, 4, 5, 6, 7), pf, o[2]);
                    o[3] = MFMA32(__builtin_shufflevector(l3, h3, 0, 1, 2, 3, 4, 5, 6, 7), pf, o[3]);
                }
        }
        asm volatile("s_waitcnt vmcnt(0)" ::: "memory");
        __syncthreads();
        tcur = tnext;
    }
}

constexpr int OST_P = 132, OST_B = 32 * OST_P * 4;
DI void stage_o(LAS float* st, const f32x16 (&o)[4], float sc, int r, int h) {
#pragma unroll
    for (int db = 0; db < 4; ++db)
#pragma unroll
        for (int qq = 0; qq < 4; ++qq) { f32x4 v; v[0] = o[db][4 * qq] * sc; v[1] = o[db][4 * qq + 1] * sc; v[2] = o[db][4 * qq + 2] * sc; v[3] = o[db][4 * qq + 3] * sc;
            *(LAS f32x4*)(st + r * OST_P + 32 * db + 8 * qq + 4 * h) = v; }
}
DI void attnA_unit(LAS unsigned char* lds, int u, const bf16_t* UA, bf16_t* OG, float* LSE) {
    const int tid = TID(), lane = tid & 63, r = lane & 31, h = lane >> 5, half = tid >> 8, wv = (tid >> 6) & 3;
    const int g = u >> 8, v = u & 255, bl = v >> 6, hd = (v >> 3) & 7;
    int d, resv[2], m0[2];
    if (g == 0) { d = 1; resv[0] = resv[1] = 0; m0[0] = (v & 7) * 256; m0[1] = m0[0] + 128; }
    else if (g == 1) { d = 4; resv[0] = resv[1] = (v >> 1) & 3; m0[0] = (v & 1) * 256; m0[1] = m0[0] + 128; }
    else { d = 16; resv[0] = (v & 7) * 2; resv[1] = resv[0] + 1; m0[0] = m0[1] = 0; }
    unsigned need[2];
#pragma unroll
    for (int hf = 0; hf < 2; ++hf) { const int lo = (m0[hf] - 128 > 0 ? m0[hf] - 128 : 0) >> 6, hi = (m0[hf] + 127) >> 6; need[hf] = ((2u << hi) - 1u) & ~((1u << lo) - 1u); }
    const int n0 = __builtin_popcount(need[0]), n1 = __builtin_popcount(need[1]);
    const int ntrip = n0 > n1 ? n0 : n1;
    const int m0h = half ? m0[1] : m0[0], res = half ? resv[1] : resv[0];
    const int mq0 = m0h + 32 * wv;
    const long tokbase = (long)bl * 2048 + res;
    AttnW w;
    w.q = UA + ((long)(g * 24 + hd) * 8192 + tokbase + (long)mq0 * d) * 128; w.qs = (long)d * 128;
    w.k = UA + ((long)(g * 24 + 8 + hd) * 8192 + tokbase) * 128; w.v = w.k + (long)8 * 8192 * 128; w.kvs = (long)d * 128;
    w.mq0 = mq0; w.maxd = 128; w.need = half ? need[1] : need[0];
    f32x16 o[4]; float m_run, l_run;
    attn_core<0, false>(lds, w, 0u, ntrip, o, m_run, l_run);
    const float inv = 1.f / l_run;
    const long tok = tokbase + (long)(mq0 + r) * d;
    { LAS float* st = (LAS float*)(lds + (tid >> 6) * OST_B);
      stage_o(st, o, inv, r, h);
      const int ch = lane & 15;
#pragma unroll
      for (int jj = 0; jj < 8; ++jj) { const int rr = 4 * jj + (lane >> 4);
          const f32x4 a = *(LAS const f32x4*)(st + rr * OST_P + ch * 8), bq = *(LAS const f32x4*)(st + rr * OST_P + ch * 8 + 4);
          u32x4 wv; wv[0] = pk2(a[0], a[1]); wv[1] = pk2(a[2], a[3]); wv[2] = pk2(bq[0], bq[1]); wv[3] = pk2(bq[2], bq[3]);
          st16_wt(OG + ((long)g * 8192 + tokbase + (long)(mq0 + rr) * d) * 1024 + hd * 128 + ch * 8, wv); } }
    if (h == 0) LSE[((long)g * 8192 + tok) * 8 + hd] = m_run * 0.6931471805599453f + __logf(l_run);
    __syncthreads();
}

template <int MODE>
DI void attnB_unit(LAS unsigned char* lds, int b, int g, int cur, const bf16_t* UB, const unsigned* SELM, const float* gate_b, bf16_t* Y) {
    const int tid = TID(), lane = tid & 63, r = lane & 31, h = lane >> 5, half = tid >> 8, wv = (tid >> 6) & 3;
    const int hq = g * 4 + wv;
    const int t0h = cur * 64 + 32 * half;
    unsigned need[2]; unsigned selm = 0u;
    if (MODE == 0) {
#pragma unroll
        for (int hf = 0; hf < 2; ++hf) { const int tt = cur * 64 + 32 * hf; const int lo = (tt - 511 > 0 ? tt - 511 : 0) >> 6; need[hf] = ((2u << cur) - 1u) & ~((1u << lo) - 1u); }
    } else {
        unsigned mk = SELM[((size_t)(b * 2 + g)) * 2048 + cur * 64 + lane];
        selm = __shfl(mk, (lane & 31) + 32 * half);
#pragma unroll
        for (int s = 1; s < 32; s <<= 1) mk |= __shfl_xor(mk, s);
        need[0] = __shfl(mk, 0); need[1] = __shfl(mk, 32);
    }
    const unsigned needu = need[0] | need[1];
    const int ntrip = __builtin_popcount(needu);
    const size_t tokb = (size_t)b * 2048;
    AttnW w;
    w.q = UB + ((size_t)hq * 32768 + tokb + t0h) * 128; w.qs = 128;
    w.k = UB + ((size_t)((MODE == 0 ? 12 : 8) + g) * 32768 + tokb) * 128; w.v = w.k + (size_t)2 * 32768 * 128; w.kvs = 128;
    w.mq0 = t0h; w.maxd = (MODE == 0) ? 511 : 1 << 20; w.need = needu;
    f32x16 o[4]; float m_run, l_run;
    attn_core<MODE, true>(lds, w, selm, ntrip, o, m_run, l_run);
    const size_t tok = tokb + t0h + r;
    const int gi = hq * 3 + (MODE == 0 ? 2 : 1);
    const bf16_t* UBZ = UB + (size_t)16 * 32768 * 128;
    const float gt = sigm(bf2f(UBZ[tok * 1056 + 1024 + gi]) + gate_b[gi]);
    const float sc = gt / l_run;
    { LAS float* st = (LAS float*)(lds + (tid >> 6) * OST_B);
      stage_o(st, o, sc, r, h);
      const int ch = lane & 15;
      u32x4 oldv[8], zzv[8];
      if (MODE == 1) {
#pragma unroll
          for (int jj = 0; jj < 8; ++jj) { const size_t tk = tokb + t0h + 4 * jj + (lane >> 4);
              oldv[jj] = *(const u32x4*)(Y + tk * 1024 + hq * 128 + ch * 8); zzv[jj] = *(const u32x4*)(UBZ + tk * 1056 + hq * 128 + ch * 8); }
          asm volatile("" ::: "memory");
      }
#pragma unroll
      for (int jj = 0; jj < 8; ++jj) { const int rr = 4 * jj + (lane >> 4); const size_t tk = tokb + t0h + rr;
          f32x4 a = *(LAS const f32x4*)(st + rr * OST_P + ch * 8), bq = *(LAS const f32x4*)(st + rr * OST_P + ch * 8 + 4);
          bf16_t* yq = Y + tk * 1024 + hq * 128 + ch * 8;
          if (MODE == 1) {
              const u32x4 old = oldv[jj], zz = zzv[jj];
              a[0] = (a[0] + bflo(old[0])) * silu(bflo(zz[0])); a[1] = (a[1] + bfhi(old[0])) * silu(bfhi(zz[0])); a[2] = (a[2] + bflo(old[1])) * silu(bflo(zz[1])); a[3] = (a[3] + bfhi(old[1])) * silu(bfhi(zz[1]));
              bq[0] = (bq[0] + bflo(old[2])) * silu(bflo(zz[2])); bq[1] = (bq[1] + bfhi(old[2])) * silu(bfhi(zz[2])); bq[2] = (bq[2] + bflo(old[3])) * silu(bflo(zz[3])); bq[3] = (bq[3] + bfhi(old[3])) * silu(bfhi(zz[3]));
          }
          u32x4 wv; wv[0] = pk2(a[0], a[1]); wv[1] = pk2(a[2], a[3]); wv[2] = pk2(bq[0], bq[1]); wv[3] = pk2(bq[2], bq[3]);
          st16_wt(yq, wv); } }
    __syncthreads();
}

DI void attnCmp_unit(LAS unsigned char* lds, int b, int g, int cur, const bf16_t* UB, const bf16_t* KC, const bf16_t* VC, const float* gate_b, bf16_t* Y, unsigned* SELM) {
    const int tid = TID(), lane = tid & 63, r = lane & 31, h = lane >> 5, wid = tid >> 6, wv = wid & 3, th = wid >> 2;
    const int hq = g * 4 + wv;
    const int t0 = cur * 64 + 32 * th;
    constexpr int CK_B = 128 * KT_P, CV_B = 128 * VT_P;
    LAS unsigned char* Kt = lds; LAS unsigned char* Vt = lds + CK_B; LAS float* arr = (LAS float*)(lds + CK_B + CV_B);
    LAS float* score = arr + 8 * 32 * 32;
    { const bf16_t* kp = KC + (size_t)(b * 2 + g) * 128 * 128; const bf16_t* vp = VC + (size_t)(b * 2 + g) * 128 * 128;
      const int skey = tid >> 4, spart = tid & 15;
#pragma unroll
      for (int i = 0; i < 4; ++i) { const int key = skey + 32 * i;
          *(LAS u32x4*)(Kt + key * KT_P + spart * 16) = *(const u32x4*)(kp + key * 128 + spart * 8);
          *(LAS u32x4*)(Vt + key * VT_P + spart * 16) = *(const u32x4*)(vp + key * 128 + spart * 8); } }
    const size_t tokb = (size_t)b * 2048;
    bf16x8 qf[8];
    { const bf16_t* qp = UB + ((size_t)hq * 32768 + tokb + t0 + r) * 128 + h * 8;
#pragma unroll
      for (int ks = 0; ks < 8; ++ks) qf[ks] = *(const bf16x8*)(qp + ks * 16); }
    __syncthreads();
    f32x16 s[4];
#pragma unroll
    for (int kb = 0; kb < 4; ++kb) {
#pragma unroll
        for (int i = 0; i < 16; ++i) s[kb][i] = 0.f;
        LAS const unsigned char* ka = Kt + (kb * 32 + r) * KT_P + h * 16;
#pragma unroll
        for (int ks = 0; ks < 8; ++ks) s[kb] = MFMA32(*(LAS const bf16x8*)(ka + ks * 32), qf[ks], s[kb]);
    }
    const int t = t0 + r;
    const int jmax = (t >= 31) ? ((t - 31) >> 4) : -1;
    float mx = -INFINITY;
#pragma unroll
    for (int kb = 0; kb < 4; ++kb)
#pragma unroll
        for (int i = 0; i < 16; ++i) { const int j = 32 * kb + (i & 3) + 8 * (i >> 2) + 4 * h; s[kb][i] = (j <= jmax) ? s[kb][i] * SCL : -INFINITY; mx = fmaxf(mx, s[kb][i]); }
    mx = fmaxf(mx, __shfl_xor(mx, 32));
    const float m_use = (mx == -INFINITY) ? 0.f : mx;
    float ls = 0.f;
#pragma unroll
    for (int kb = 0; kb < 4; ++kb)
#pragma unroll
        for (int i = 0; i < 16; ++i) { s[kb][i] = __builtin_amdgcn_exp2f(s[kb][i] - m_use); ls += s[kb][i]; }
    ls += __shfl_xor(ls, 32);
    const float inv = 1.f / fmaxf(ls, 1e-30f);
#pragma unroll
    for (int kb = 0; kb < 4; ++kb)
#pragma unroll
        for (int i = 0; i < 16; ++i) s[kb][i] *= inv;
    {
        LAS float* ap = arr + (wid * 32 + r) * 32;
#pragma unroll
        for (int kb = 0; kb < 4; ++kb)
#pragma unroll
            for (int qd = 0; qd < 4; ++qd) {
                const float qs = s[kb][4 * qd] + s[kb][4 * qd + 1] + s[kb][4 * qd + 2] + s[kb][4 * qd + 3];
                const float lastv = s[kb][4 * qd + 3];
                const float prevsame = (kb == 0 && qd == 0) ? 0.f : ((qd == 0) ? s[kb - (kb > 0)][15] : s[kb][4 * qd - 1]);
                const float send = h ? prevsame : lastv;
                const float recv = __shfl_xor(send, 32);
                ap[8 * kb + 2 * qd + h] = qs + recv;
            }
    }
    f32x16 o[4];
#pragma unroll
    for (int db = 0; db < 4; ++db)
#pragma unroll
        for (int i = 0; i < 16; ++i) o[db][i] = 0.f;
    {
        const int i16 = lane & 15, q4 = i16 >> 2, pp = i16 & 3, blk = (lane >> 4) & 1;
        LAS const unsigned char* va = Vt + (4 * h + q4) * VT_P + (16 * blk + 4 * pp) * 2;
#pragma unroll
        for (int kb = 0; kb < 4; ++kb)
#pragma unroll
            for (int s2 = 0; s2 < 2; ++s2) {
                const bf16x8 pf = pack8(s[kb], s2);
                LAS const unsigned char* vb = va + (kb * 32 + 16 * s2) * VT_P;
#pragma unroll
                for (int db = 0; db < 4; ++db) {
                    const s16x4 lo = trrd(vb + db * 64), hi = trrd(vb + 8 * VT_P + db * 64);
                    o[db] = MFMA32(__builtin_shufflevector(lo, hi, 0, 1, 2, 3, 4, 5, 6, 7), pf, o[db]);
                }
            }
    }
    __syncthreads();
#pragma unroll
    for (int i = 0; i < 4; ++i) {
        const int pidx = tid + 512 * i, tt = pidx >> 5, n = pidx & 31;
        const int wb = (tt >> 5) * 4, tr_ = tt & 31;
        float sc = arr[((wb + 0) * 32 + tr_) * 32 + n] + arr[((wb + 1) * 32 + tr_) * 32 + n] + arr[((wb + 2) * 32 + tr_) * 32 + n] + arr[((wb + 3) * 32 + tr_) * 32 + n];
        if (n > cur) sc = -INFINITY; else if (n == 0 || n == cur || n == cur - 1) sc = 1000.f;
        score[tt * 32 + n] = sc;
    }
    __syncthreads();
#pragma unroll
    for (int i = 0; i < 4; ++i) {
        const int pidx = tid + 512 * i, tt = pidx >> 5, n = pidx & 31;
        const float me = score[tt * 32 + n];
        int rank = 0;
        for (int n2 = 0; n2 < 32; ++n2) { const float ot = score[tt * 32 + n2]; rank += (ot > me || (ot == me && n2 < n)) ? 1 : 0; }
        const bool selb = (n <= cur) && (rank < 16);
        const unsigned long long bal = __ballot(selb);
        if ((lane & 31) == 0) SELM[((size_t)(b * 2 + g)) * 2048 + cur * 64 + tt] = (unsigned)(lane ? (bal >> 32) : (bal & 0xffffffffull));
    }
    __syncthreads();
    {
        const size_t tok = tokb + t;
        const int gi = hq * 3;
        const float gt = sigm(bf2f(UB[(size_t)16 * 32768 * 128 + tok * 1056 + 1024 + gi]) + gate_b[gi]);
        LAS float* st = (LAS float*)(lds + wid * OST_B);
        stage_o(st, o, gt, r, h);
        const int ch = lane & 15;
        u32x4 oldv[8];
#pragma unroll
        for (int jj = 0; jj < 8; ++jj) oldv[jj] = *(const u32x4*)(Y + (tokb + t0 + 4 * jj + (lane >> 4)) * 1024 + hq * 128 + ch * 8);
        asm volatile("" ::: "memory");
#pragma unroll
        for (int jj = 0; jj < 8; ++jj) { const int rr = 4 * jj + (lane >> 4); const size_t tk = tokb + t0 + rr;
            const f32x4 a = *(LAS const f32x4*)(st + rr * OST_P + ch * 8), bq = *(LAS const f32x4*)(st + rr * OST_P + ch * 8 + 4);
            bf16_t* yq = Y + tk * 1024 + hq * 128 + ch * 8;
            const u32x4 old = oldv[jj];
            u32x4 wv; wv[0] = pk2(a[0] + bflo(old[0]), a[1] + bfhi(old[0])); wv[1] = pk2(a[2] + bflo(old[1]), a[3] + bfhi(old[1]));
            wv[2] = pk2(bq[0] + bflo(old[2]), bq[1] + bfhi(old[2])); wv[3] = pk2(bq[2] + bflo(old[3]), bq[3] + bfhi(old[3]));
            st16_wt(yq, wv); }
    }
    __syncthreads();
}

DI float wave_sum(float v) {
#pragma unroll
    for (int s = 32; s > 0; s >>= 1) v += __shfl_xor(v, s);
    return v;
}
template <bool FINAL>
DI void norm_phase(PR p, const float* x, const float* gain, bf16_t* xb, float* outp) {
    const int tid_ = TID(); const int lane = tid_ & 63, wid = tid_ >> 6;
    f32x4 gg[4];
#pragma unroll
    for (int i = 0; i < 4; ++i) gg[i] = *(const f32x4*)(gain + lane * 4 + 256 * i);
    constexpr int NR = 4;
    for (int row0 = (BID() * 8 + wid) * NR; row0 < 32768; row0 += NBLK() * 8 * NR) {
        f32x4 v[NR][4]; float ss[NR];
#pragma unroll
        for (int q = 0; q < NR; ++q)
#pragma unroll
            for (int i = 0; i < 4; ++i) v[q][i] = *(const f32x4*)(x + (size_t)(row0 + q) * 1024 + lane * 4 + 256 * i);
#pragma unroll
        for (int q = 0; q < NR; ++q) { ss[q] = 0.f;
#pragma unroll
            for (int i = 0; i < 4; ++i) ss[q] += v[q][i][0] * v[q][i][0] + v[q][i][1] * v[q][i][1] + v[q][i][2] * v[q][i][2] + v[q][i][3] * v[q][i][3];
            ss[q] = wave_sum(ss[q]); }
#pragma unroll
        for (int q = 0; q < NR; ++q) {
            const float rs = rsqrtf(ss[q] * (1.f / 1024.f) + 1e-6f);
#pragma unroll
            for (int i = 0; i < 4; ++i) {
                const f32x4 y = v[q][i] * rs * gg[i];
                if (FINAL) st16f_wt(outp + (size_t)(row0 + q) * 1024 + lane * 4 + 256 * i, y);
                else { u32x2 w; w[0] = pk2(y[0], y[1]); w[1] = pk2(y[2], y[3]); st8_wt(xb + (size_t)(row0 + q) * 1024 + lane * 4 + 256 * i, w); }
            }
        }
    }
}

struct TJob { const float* src; bf16_t* dst; int K, N, Npad, ldd, mode; };
DI int head_perm(int pos) { const int wc = pos >> 5, fq = (pos >> 3) & 3, e = pos & 7; return fq == 0 ? (e < 4 ? 4 * wc + e : 12 + 4 * wc + e) : 32 + (wc * 3 + fq - 1) * 8 + e; }
DI int src_col(int mode, int n) {
    const int hh = n >> 7; bool pm = false;
    if (mode == 1) pm = hh < 72 && ((hh % 24) < 16);
    if (mode == 2) pm = hh < 8 || hh == 12 || hh == 13 || hh == 16 || hh == 17;
    if (mode == 3) pm = true;
    return pm ? (hh << 7) + head_perm(n & 127) : n;
}
DI TJob get_job(PR p, int id) {
    unsigned char* ws = p.ws; TJob j;
    if (id < 2) j = {p.a_w_in + (size_t)id * 1024 * 10240, (bf16_t*)(ws + OFF_WAIN) + (size_t)id * 10240 * 1024, 1024, 10240, 10240, 1024, 1};
    else if (id < 4) j = {p.a_w_out + (size_t)(id - 2) * 1024 * 1024, (bf16_t*)(ws + OFF_WAOUT) + (size_t)(id - 2) * 1024 * 1024, 1024, 1024, 1024, 1024, 0};
    else if (id == 4) j = {p.b_w_in, (bf16_t*)(ws + OFF_WBIN), 1024, 3608, 3840, 1024, 2};
    else if (id == 5) j = {p.b_w_out, (bf16_t*)(ws + OFF_WBOUT), 1024, 1024, 1024, 1024, 0};
    else if (id == 6) j = {p.c_w_in, (bf16_t*)(ws + OFF_WCIN), 1024, 2560, 2560, 1024, 0};
    else if (id == 7) j = {p.c_w_out, (bf16_t*)(ws + OFF_WCOUT), 1280, 1024, 1024, 1280, 0};
    else if (id == 8) j = {p.b_w1_k, (bf16_t*)(ws + OFF_WCMP1), 4096, 128, 128, 4096, 0};
    else if (id == 9) j = {p.b_w1_v, (bf16_t*)(ws + OFF_WCMP1) + (size_t)128 * 4096, 4096, 128, 128, 4096, 0};
    else if (id == 10) j = {p.b_w2_k, (bf16_t*)(ws + OFF_WCMP2), 128, 128, 128, 256, 3};
    else if (id == 11) j = {p.b_w2_v, (bf16_t*)(ws + OFF_WCMP2) + 128 * 256 + 128, 128, 128, 128, 256, 0};
    else if (id == 12) j = {p.b_w2_k, (bf16_t*)(ws + OFF_WCMP2) + 128, 128, 0, 128, 256, 0};
    else if (id == 13) j = {p.b_w2_k, (bf16_t*)(ws + OFF_WCMP2) + 128 * 256, 128, 0, 128, 256, 0};
    else if (id < 24) j = {p.c_wa + (size_t)(id - 14) * 128 * 128, (bf16_t*)(ws + OFF_WGATE) + (size_t)(id - 14) * 256 * 128, 128, 128, 128, 128, 0};
    else j = {p.c_wx + (size_t)(id - 24) * 128 * 128, (bf16_t*)(ws + OFF_WGATE) + (size_t)(id - 24) * 256 * 128 + 128 * 128, 128, 128, 128, 128, 0};
    return j;
}
DI void prep_phase(PR p, LAS unsigned char* lds) {
    const int tid = TID();
    LAS float* sm = (LAS float*)lds;
    int rot = 0;
    const int nbk = NBLK(), bidk = BID();
    for (int id = 0; id < 34; ++id) {
        const TJob j = get_job(p, id);
        const int tk = j.K / 64, ntile = tk * (j.Npad / 64);
        int t0 = bidk - rot; if (t0 < 0) t0 += nbk;
        rot = (rot + ntile) % nbk;
        for (int tile = t0; tile < ntile; tile += nbk) {
            const int k0 = (tile % tk) * 64, n0 = (tile / tk) * 64;
#pragma unroll
            for (int i = 0; i < 8; ++i) { const int idx = tid + 512 * i, kk = idx >> 6, nn = idx & 63;
                sm[kk * 65 + nn] = (n0 + nn < j.N) ? j.src[(size_t)(k0 + kk) * j.N + src_col(j.mode, n0 + nn)] : 0.f; }
            __syncthreads();
#pragma unroll
            for (int i = 0; i < 4; ++i) { const int idx = tid + 512 * i, nn = idx >> 5, kp = idx & 31;
                *(unsigned*)(j.dst + (size_t)(n0 + nn) * j.ldd + k0 + 2 * kp) = pk2(sm[(2 * kp) * 65 + nn], sm[(2 * kp + 1) * 65 + nn]); }
            __syncthreads();
        }
    }
    { float* rt = (float*)(p.ws + OFF_ROPE);
      for (int idx = BID() * 512 + tid; idx < 2048 * 16; idx += NBLK() * 512) { const int t = idx >> 4, i = idx & 15;
          const float inv_freq = powf(500000.f, -2.f * (float)i / 32.f); const float ang = (float)t * inv_freq;
          rt[t * 32 + i] = cosf(ang); rt[t * 32 + 16 + i] = sinf(ang); } }
    if (BID() == 0) { float* sp = (float*)(p.ws + OFF_SP8); for (int c = tid; c < 1280; c += 512) sp[c] = -8.f * log1pf(expf(-p.c_lambda[c])); }
    if (tid < 256) {
        const int e = tid & 127, which = tid >> 7;
        const float* pe = which ? p.b_pe_v : p.b_pe_k; const float* w1 = which ? p.b_w1_v : p.b_w1_k;
        float a = 0.f;
        for (int pd = BID(); pd < 4096; pd += NBLK()) a += pe[pd] * w1[(size_t)pd * 128 + e];
        ((float*)(p.ws + OFF_BPART))[(size_t)BID() * 256 + tid] = a;
    }
    norm_phase<false>(p, p.x, p.norm_g, (bf16_t*)(p.ws + OFF_XB), nullptr);
}

DI void mergeA_phase(PR p, int row0g) {
    const bf16_t* OG = (const bf16_t*)(p.ws + OFF_OG); const float* LSE = (const float*)(p.ws + OFF_LSE);
    const bf16_t* ZA = (const bf16_t*)(p.ws + OFF_ZA); bf16_t* Y = (bf16_t*)(p.ws + OFF_XB);
    for (int idx = BID() * 512 + TID(); idx < 8192 * 128; idx += NBLK() * 512) {
        const int tokl = idx >> 7, c8 = idx & 127, hd = c8 >> 4, col = c8 * 8;
        const float l0 = LSE[((size_t)0 * 8192 + tokl) * 8 + hd], l1 = LSE[((size_t)1 * 8192 + tokl) * 8 + hd], l2 = LSE[((size_t)2 * 8192 + tokl) * 8 + hd];
        const float mx = fmaxf(l0, fmaxf(l1, l2));
        float w0 = __expf(l0 - mx), w1 = __expf(l1 - mx), w2 = __expf(l2 - mx);
        const float inv = 1.f / (w0 + w1 + w2); w0 *= inv; w1 *= inv; w2 *= inv;
        const u32x4 a0 = *(const u32x4*)(OG + ((size_t)0 * 8192 + tokl) * 1024 + col), a1 = *(const u32x4*)(OG + ((size_t)1 * 8192 + tokl) * 1024 + col), a2 = *(const u32x4*)(OG + ((size_t)2 * 8192 + tokl) * 1024 + col);
        const u32x4 zz = *(const u32x4*)(ZA + (size_t)(row0g + tokl) * 1024 + col);
        u32x4 out;
#pragma unroll
        for (int e = 0; e < 4; ++e) {
            const float lo = (w0 * bflo(a0[e]) + w1 * bflo(a1[e]) + w2 * bflo(a2[e])) * silu(bflo(zz[e]));
            const float hi = (w0 * bfhi(a0[e]) + w1 * bfhi(a1[e]) + w2 * bfhi(a2[e])) * silu(bfhi(zz[e]));
            out[e] = pk2(lo, hi);
        }
        st16_wt(Y + (size_t)(row0g + tokl) * 1024 + col, out);
    }
}

DI void gate_phase(PR p, LAS unsigned char* lds) {
    const int tid = TID(), lane = tid & 63, wid = tid >> 6, r = lane & 31, h = lane >> 5;
    const int c = BID(), qg = NBLK() / 10;
    if (c >= qg * 10) return;
    const int n = c % 10;
    const bf16_t* Bt = (const bf16_t*)(p.ws + OFF_WGATE) + (size_t)n * 256 * 128;
    bf16_t* XC = (bf16_t*)(p.ws + OFF_XC); unsigned* AB = (unsigned*)(p.ws + OFF_AB); const bf16_t* XR = (const bf16_t*)(p.ws + OFF_XRAW);
#pragma unroll
    for (int i = 0; i < 8; ++i) { const int idx = tid + 512 * i, row = idx >> 4, part = idx & 15;
        *(LAS u32x4*)(lds + row * KT_P + part * 16) = *(const u32x4*)(Bt + row * 128 + part * 8); }
    LAS float* cwl0 = (LAS float*)(lds + 256 * KT_P);
    for (int idx = tid; idx < 640; idx += 512) { const int w = idx >> 7, c = idx & 127; cwl0[idx] = (w < 4) ? p.c_conv_w[w * 1280 + n * 128 + c] : p.c_conv_b[n * 128 + c]; }
    __syncthreads();
    const float* ba = p.c_ba + n * 128; const float* bx = p.c_bx + n * 128; const float* sp8 = (const float*)(p.ws + OFF_SP8) + n * 128;
    for (int pm = c / 10; pm < 128; pm += qg) {
        const size_t row = (size_t)pm * 256 + wid * 32 + r;
        const int t = (int)(row & 2047);
        bf16x8 af[8];
#pragma unroll
        for (int ks = 0; ks < 8; ++ks) {
            const int c0 = n * 128 + ks * 16 + h * 8;
            LAS const float* cwl = cwl0 + ks * 16 + h * 8;
            const f32x4 b0 = *(LAS const f32x4*)(cwl + 512), b1 = *(LAS const f32x4*)(cwl + 516);
            float a[8] = {b0[0], b0[1], b0[2], b0[3], b1[0], b1[1], b1[2], b1[3]};
#pragma unroll
            for (int w = 0; w < 4; ++w) {
                if (t + w - 3 < 0) continue;
                const u32x4 xv = *(const u32x4*)(XR + (row + w - 3) * 1280 + c0);
                const f32x4 w0 = *(LAS const f32x4*)(cwl + w * 128), w1 = *(LAS const f32x4*)(cwl + w * 128 + 4);
                a[0] += w0[0] * bflo(xv[0]); a[1] += w0[1] * bfhi(xv[0]); a[2] += w0[2] * bflo(xv[1]); a[3] += w0[3] * bfhi(xv[1]);
                a[4] += w1[0] * bflo(xv[2]); a[5] += w1[1] * bfhi(xv[2]); a[6] += w1[2] * bflo(xv[3]); a[7] += w1[3] * bfhi(xv[3]);
            }
            u32x4 o; o[0] = pk2(a[0], a[1]); o[1] = pk2(a[2], a[3]); o[2] = pk2(a[4], a[5]); o[3] = pk2(a[6], a[7]);
            af[ks] = __builtin_bit_cast(bf16x8, o);
            if ((ks & 3) == 3) asm volatile("" ::: "memory");
        }
#pragma unroll
        for (int ob = 0; ob < 4; ++ob) {
            f32x16 ar, ai;
#pragma unroll
            for (int i = 0; i < 16; ++i) { ar[i] = 0.f; ai[i] = 0.f; }
            asm volatile("" ::: "memory");
            LAS const unsigned char* bp = lds + (32 * ob + r) * KT_P + h * 16;
#pragma unroll
            for (int ks = 0; ks < 8; ++ks) {
                const bf16x8 br = *(LAS const bf16x8*)(bp + ks * 32), bi = *(LAS const bf16x8*)(bp + 128 * KT_P + ks * 32);
                ar = MFMA32(br, af[ks], ar); ai = MFMA32(bi, af[ks], ai);
            }
#pragma unroll
            for (int q4 = 0; q4 < 4; ++q4) {
                const int chl = 32 * ob + 8 * q4 + 4 * h;
                const f32x4 vba = *(const f32x4*)(ba + chl), vbx = *(const f32x4*)(bx + chl), sp = *(const f32x4*)(sp8 + chl);
                const u32x4 fw = __builtin_bit_cast(u32x4, af[2 * ob + (q4 >> 1)]);
                const unsigned own0 = h ? fw[2] : fw[0], own1 = h ? fw[3] : fw[1], snd0 = h ? fw[0] : fw[2], snd1 = h ? fw[1] : fw[3];
                const unsigned rc0 = __shfl_xor(snd0, 32), rc1 = __shfl_xor(snd1, 32);
                const unsigned x0 = (h == (q4 & 1)) ? own0 : rc0, x1 = (h == (q4 & 1)) ? own1 : rc1;
                const float xv[4] = {bflo(x0), bfhi(x0), bflo(x1), bfhi(x1)};
                u32x4 w;
#pragma unroll
                for (int e = 0; e < 4; ++e) {
                    const float la = sigm(ar[4 * q4 + e] + vba[e]) * sp[e];
                    const float a2 = __builtin_amdgcn_exp2f(la * 2.8853900817779268f);
                    const float bb = __builtin_sqrtf(fmaxf(1.f - a2, 0.f)) * sigm(ai[4 * q4 + e] + vbx[e]) * xv[e];
                    w[e] = pk2(la, bb);
                }
                *(u32x4*)(AB + row * 1280 + n * 128 + chl) = w;
            }
        }
    }
}
DI void conv_phase(PR p) {
    const bf16_t* XR = (const bf16_t*)(p.ws + OFF_XRAW); bf16_t* XC = (bf16_t*)(p.ws + OFF_XC);
    for (int idx = BID() * 512 + TID(); idx < 32768 * 160; idx += NBLK() * 512) {
        const int tok = idx / 160, c0 = (idx % 160) * 8, t = tok & 2047;
        float a[8];
#pragma unroll
        for (int e = 0; e < 8; ++e) a[e] = p.c_conv_b[c0 + e];
#pragma unroll
        for (int w = 0; w < 4; ++w) {
            if (t + w - 3 < 0) continue;
            const u32x4 xv = *(const u32x4*)(XR + (size_t)(tok + w - 3) * 1280 + c0);
            const float* cw = p.c_conv_w + w * 1280 + c0;
#pragma unroll
            for (int e = 0; e < 4; ++e) { a[2 * e] += cw[2 * e] * bflo(xv[e]); a[2 * e + 1] += cw[2 * e + 1] * bfhi(xv[e]); }
        }
        u32x4 o; o[0] = pk2(a[0], a[1]); o[1] = pk2(a[2], a[3]); o[2] = pk2(a[4], a[5]); o[3] = pk2(a[6], a[7]);
        *(u32x4*)(XC + (size_t)tok * 1280 + c0) = o;
    }
}
template <int PASS>
DI void scan_phase(PR p) {
    const unsigned* AB = (const unsigned*)(p.ws + OFF_AB); f32x2* CARRY = (f32x2*)(p.ws + OFF_CARRY);
    const bf16_t* ZC = (const bf16_t*)(p.ws + OFF_ZC); bf16_t* Y = (bf16_t*)(p.ws + OFF_XRAW);
    const bf16_t* XC = (const bf16_t*)(p.ws + OFF_XC); const float* SP8 = (const float*)(p.ws + OFF_SP8);
    const int tid = TID();
    const int nch = (tid < 256) ? 3 : 2;
    for (int item = BID(); item < 512; item += NBLK()) {
        const int b = item >> 5, ck = item & 31;
        float hh[3] = {0.f, 0.f, 0.f}, P[3] = {1.f, 1.f, 1.f}, sp[3];
#pragma unroll
        for (int k = 0; k < 3; ++k) sp[k] = (k < nch) ? SP8[tid + 512 * k] * 1.4426950408889634f : 0.f;
        if (PASS == 1) {
            for (int c0 = 0; c0 < ck; c0 += 8) {
                f32x2 cv[8][3];
#pragma unroll
                for (int q = 0; q < 8; ++q)
#pragma unroll
                    for (int k = 0; k < 3; ++k) { cv[q][k][0] = 1.f; cv[q][k][1] = 0.f; if (k < nch && c0 + q < ck) cv[q][k] = CARRY[((size_t)(b * 32 + c0 + q)) * 1280 + tid + 512 * k]; }
#pragma unroll
                for (int q = 0; q < 8; ++q)
#pragma unroll
                    for (int k = 0; k < 3; ++k) hh[k] = cv[q][k][0] * hh[k] + cv[q][k][1];
            }
        }
        const size_t base = ((size_t)b * 2048 + ck * 64) * 1280 + tid;
        for (int tb = 0; tb < 4; ++tb) {
            unsigned ab[3][16]; bf16_t zz[3][16];
#pragma unroll
            for (int k = 0; k < 3; ++k)
#pragma unroll
                for (int j = 0; j < 16; ++j) if (k < nch) { const size_t o = base + (size_t)(tb * 16 + j) * 1280 + 512 * k; ab[k][j] = AB[o]; if (PASS == 1) zz[k][j] = ZC[o]; }
#pragma unroll
            for (int k = 0; k < 3; ++k)
#pragma unroll
                for (int j = 0; j < 16; ++j) if (k < nch) {
                    const float a = __builtin_amdgcn_exp2f(bflo(ab[k][j]) * 1.4426950408889634f);
                    const float bb = bfhi(ab[k][j]);
                    hh[k] = a * hh[k] + bb; P[k] *= a;
                    if (PASS == 1) { const size_t o = base + (size_t)(tb * 16 + j) * 1280 + 512 * k; Y[o] = (bf16_t)(pk2(hh[k] * silu(bf2f(zz[k][j])), 0.f) & 0xffffu); }
                }
        }
        if (PASS == 0) {
#pragma unroll
            for (int k = 0; k < 3; ++k) if (k < nch) { f32x2 c; c[0] = P[k]; c[1] = hh[k]; CARRY[((size_t)(b * 32 + ck)) * 1280 + tid + 512 * k] = c; }
        }
    }
}

#define XB_TMO      128
#define XB_XCNT(j)  (256  + 64 * (j))
#define XB_XSUB(j)  (1280 + 64 * (j))
#define XB_XGEN(j)  (2304 + 64 * (j))
#define XB_TOP      3328
#define XB_TOPGEN   3392
#define XCD_BAR_WORDS 3456
#define XB_SPIN_CAP (1u << 22)
DI unsigned xb_ld(unsigned* p) { return __hip_atomic_load(p, __ATOMIC_RELAXED, __HIP_MEMORY_SCOPE_AGENT); }
DI unsigned xb_add(unsigned* p, unsigned v) { return __hip_atomic_fetch_add(p, v, __ATOMIC_RELAXED, __HIP_MEMORY_SCOPE_AGENT); }
DI unsigned xb_xcc_id() { return (unsigned)__builtin_amdgcn_s_getreg((3 << 11) | 20) & 0xFu; }
#define XB_SPIN(cond, bar) do { unsigned _sp = 0; while (cond) { __builtin_amdgcn_s_sleep(1); \
    if ((++_sp & 255u) == 0u) { if (xb_ld(&(bar)[XB_TMO])) break; if (_sp > XB_SPIN_CAP) { atomicAdd(&(bar)[XB_TMO], 1u); break; } } } } while (0)
struct XcdBarrier { unsigned* bar; unsigned x; volatile LAS unsigned* st; };
DI XcdBarrier xcd_barrier_post(unsigned* bar, volatile LAS unsigned* st) {
    XcdBarrier b; b.bar = bar; b.x = xb_xcc_id(); b.st = st;
    if (threadIdx.x == 0) (void)xb_add(&bar[XB_XCNT(b.x)], 1u);
    return b;
}
DI void xcd_barrier_complete(unsigned* bar, unsigned x, unsigned& nloc, unsigned& nx) {
    const unsigned G = gridDim.x * gridDim.y * gridDim.z;
    unsigned sum, cnt, mine, sp = 0u;
    for (;;) {
        sum = 0u; cnt = 0u; mine = 0u;
#pragma unroll
        for (unsigned j = 0; j < 16; ++j) { const unsigned c = xb_ld(&bar[XB_XCNT(j)]); sum += c; cnt += (c > 0u) ? 1u : 0u; mine = (j == x) ? c : mine; }
        if (sum == G) break;
        __builtin_amdgcn_s_sleep(1);
        if ((++sp & 255u) == 0u) { if (xb_ld(&bar[XB_TMO])) break; if (sp > XB_SPIN_CAP) { atomicAdd(&bar[XB_TMO], 1u); break; } }
    }
    nloc = mine > 0u ? mine : 1u; nx = cnt > 0u ? cnt : 1u;
}
DI void xcd_barrier(const XcdBarrier& b) {
    asm volatile("s_waitcnt vmcnt(0)" ::: "memory");
    __syncthreads();
    if (threadIdx.x == 0) {
        unsigned* bar = b.bar;
        __builtin_amdgcn_s_waitcnt(0);
        unsigned nloc = b.st[0], nx = b.st[1];
        if (nloc == 0u) { xcd_barrier_complete(bar, b.x, nloc, nx); b.st[0] = nloc; b.st[1] = nx; }
        const unsigned old = xb_add(&bar[XB_XSUB(b.x)], 1u);
        const unsigned gen = old / nloc;
        if (old + 1u == (gen + 1u) * nloc) {
            __builtin_amdgcn_fence(__ATOMIC_RELEASE, "agent");
            asm volatile("s_waitcnt vmcnt(0)" ::: "memory");
            const unsigned og = xb_add(&bar[XB_TOP], 1u);
            const unsigned tg = og / nx;
            if (og + 1u == (tg + 1u) * nx) xb_add(&bar[XB_TOPGEN], 1u);
            else XB_SPIN(xb_ld(&bar[XB_TOPGEN]) == tg, bar);
            __builtin_amdgcn_fence(__ATOMIC_ACQUIRE, "agent");
            xb_add(&bar[XB_XGEN(b.x)], 1u);
            asm volatile("s_waitcnt vmcnt(0)" ::: "memory");
        } else {
            XB_SPIN(xb_ld(&bar[XB_XGEN(b.x)]) == gen, bar);
            __builtin_amdgcn_fence(__ATOMIC_ACQUIRE, "agent");
            asm volatile("s_waitcnt vmcnt(0)" ::: "memory");
        }
    }
    __syncthreads();
}

constexpr int PH_A0 = 1, PH_B = 12, PH_C = 19, PH_A1 = 25, PH_END = 36;

template <class Epi> DI void run_gemm(PR p, LAS unsigned char* lds, const bf16_t* A, const bf16_t* Bt, int M, int N, int K, int lda, int apn, const Epi& E) {
    pg8::Gemm g; g.A = A; g.Bt = Bt; g.M = M; g.N = N; g.K = K; g.lda = lda; g.apn = apn;
    pg8::StaticOrder S; S.init(M, N, NBLK(), BID());
    pg8::gemm_phase<Epi>(lds, g, S, E);
}

DI void gemmA_in(PR p, LAS unsigned char* lds, int j, int c) {
    EpiU<0> E; E.Z2 = nullptr; E.U = (bf16_t*)(p.ws + OFF_UA); E.Z = (bf16_t*)(p.ws + OFF_ZA) + (size_t)c * 8192 * 1024; E.rope = (const float*)(p.ws + OFF_ROPE);
    run_gemm(p, lds, (const bf16_t*)(p.ws + OFF_XB) + (size_t)c * 8192 * 1024, (const bf16_t*)(p.ws + OFF_WAIN) + (size_t)j * 10240 * 1024, 8192, 10240, 1024, 1024, 0, E);
}
DI void gemm_out(PR p, LAS unsigned char* lds, const bf16_t* Y, const bf16_t* Wt, int K, bool first) {
    EpiRes E; E.xin = first ? p.x : p.out; E.xout = p.out;
    run_gemm(p, lds, Y, Wt, 32768, 1024, K, K, 0, E);
}

DI void layerA_phase(PR p, LAS unsigned char* lds, int s, int j, int li) {
    if (s <= 8) {
        if ((s & 1) == 0) {
            const int c = s >> 1;
            if (c > 0) mergeA_phase(p, (c - 1) * 8192);
            if (c < 4) gemmA_in(p, lds, j, c);
        } else {
            const int c = BID();
            if (NBLK() == 256) { for (int k = 0; k < 3; ++k) attnA_unit(lds, k * 256 + (((c & 7) << 5) | (c >> 3)), (const bf16_t*)(p.ws + OFF_UA), (bf16_t*)(p.ws + OFF_OG), (float*)(p.ws + OFF_LSE)); }
            else for (int u = c; u < 768; u += NBLK()) attnA_unit(lds, u, (const bf16_t*)(p.ws + OFF_UA), (bf16_t*)(p.ws + OFF_OG), (float*)(p.ws + OFF_LSE));
        }
    } else if (s == 9) {
        gemm_out(p, lds, (const bf16_t*)(p.ws + OFF_XB), (const bf16_t*)(p.ws + OFF_WAOUT) + (size_t)j * 1024 * 1024, 1024, li == 0);
    } else {
        if (li == 3) norm_phase<true>(p, p.out, p.final_g, nullptr, p.out);
        else norm_phase<false>(p, p.out, p.norm_g + (li + 1) * 1024, (bf16_t*)(p.ws + OFF_XB), nullptr);
    }
}
DI void bunit(int u, int& b, int& g, int& cur) {
    const int k = u >> 8, c = u & 255, x = c >> 5, bg = c & 31;
    const int base = 31 - 8 * k; cur = (k & 1) ? base - 7 + x : base - x; b = bg >> 1; g = bg & 1;
}
DI void layerB_phase(PR p, LAS unsigned char* lds, int s) {
    bf16_t* UB = (bf16_t*)(p.ws + OFF_UB); bf16_t* Y = (bf16_t*)(p.ws + OFF_XB);
    if (s == 0) {
        { const int tid = TID(), nb = NBLK(); const float* bp = (const float*)(p.ws + OFF_BPART); LAS float* red = (LAS float*)lds;
          for (int o = BID(); o < 256; o += nb) {
              float a = 0.f;
              for (int w = tid; w < nb; w += 512) a += bp[(size_t)w * 256 + o];
              a = wave_sum(a);
              __syncthreads();
              if ((tid & 63) == 0) red[tid >> 6] = a;
              __syncthreads();
              if (tid == 0) ((float*)(p.ws + OFF_BIAS1))[o] = red[0] + red[1] + red[2] + red[3] + red[4] + red[5] + red[6] + red[7];
          }
          __syncthreads(); }
        EpiU<1> E; E.U = UB; E.Z = (bf16_t*)(p.ws + OFF_KVC); E.Z2 = (bf16_t*)(p.ws + OFF_UBZ); E.rope = (const float*)(p.ws + OFF_ROPE);
        run_gemm(p, lds, (const bf16_t*)(p.ws + OFF_XB), (const bf16_t*)(p.ws + OFF_WBIN), 32768, 3840, 1024, 1024, 0, E);
    } else if (s == 1) {
        if (BID() < 32) { EpiCmp1 E; E.H = (bf16_t*)(p.ws + OFF_HB); E.bias = (const float*)(p.ws + OFF_BIAS1);
            pg8::Gemm g; g.A = (const bf16_t*)(p.ws + OFF_KVC); g.Bt = (const bf16_t*)(p.ws + OFF_WCMP1); g.M = 8192; g.N = 256; g.K = 4096; g.lda = 2048; g.apn = 0;
            pg8::StaticOrder S; S.init(8192, 256, 32, BID());
            pg8::gemm_phase<EpiCmp1>(lds, g, S, E); }
        unsigned* ctr = (unsigned*)(p.ws + OFF_BAR + XCD_BAR_BYTES);
        volatile LAS unsigned* stq = (volatile LAS unsigned*)(lds + LDS_WORK + 8);
        for (;;) {
            __syncthreads();
            if (TID() == 0) stq[0] = __hip_atomic_fetch_add(ctr, 1u, __ATOMIC_RELAXED, __HIP_MEMORY_SCOPE_AGENT);
            __syncthreads();
            const unsigned u = stq[0];
            if (u >= 1024u) break;
            int b, g, cur; bunit((int)u, b, g, cur); attnB_unit<0>(lds, b, g, cur, UB, nullptr, p.b_gate_b, Y);
        }
    } else if (s == 2) {
        EpiCmp2 E; E.KC = (bf16_t*)(p.ws + OFF_KC); E.VC = (bf16_t*)(p.ws + OFF_VC);
        run_gemm(p, lds, (const bf16_t*)(p.ws + OFF_HB), (const bf16_t*)(p.ws + OFF_WCMP2), 8192, 256, 256, 256, 0, E);
    } else if (s == 3) {
        for (int u = BID(); u < 1024; u += NBLK()) { int b, g, cur; bunit(u, b, g, cur);
            attnCmp_unit(lds, b, g, cur, UB, (const bf16_t*)(p.ws + OFF_KC), (const bf16_t*)(p.ws + OFF_VC), p.b_gate_b, Y, (unsigned*)(p.ws + OFF_SELM)); }
    } else if (s == 4) {
        for (int u = BID(); u < 1024; u += NBLK()) { int b, g, cur; bunit(u, b, g, cur); attnB_unit<1>(lds, b, g, cur, UB, (const unsigned*)(p.ws + OFF_SELM), p.b_gate_b, Y); }
    } else if (s == 5) {
        gemm_out(p, lds, Y, (const bf16_t*)(p.ws + OFF_WBOUT), 1024, false);
    } else {
        norm_phase<false>(p, p.out, p.norm_g + 2 * 1024, (bf16_t*)(p.ws + OFF_XB), nullptr);
    }
}
DI void layerC_phase(PR p, LAS unsigned char* lds, int s) {
    if (s == 0) {
        EpiU<2> E; E.Z2 = nullptr; E.U = (bf16_t*)(p.ws + OFF_XRAW); E.Z = (bf16_t*)(p.ws + OFF_ZC); E.rope = nullptr;
        run_gemm(p, lds, (const bf16_t*)(p.ws + OFF_XB), (const bf16_t*)(p.ws + OFF_WCIN), 32768, 2560, 1024, 1024, 0, E);
    } else if (s == 1) gate_phase(p, lds);
    else if (s == 2) scan_phase<0>(p);
    else if (s == 3) scan_phase<1>(p);
    else if (s == 4) gemm_out(p, lds, (const bf16_t*)(p.ws + OFF_XRAW), (const bf16_t*)(p.ws + OFF_WCOUT), 1280, false);
    else norm_phase<false>(p, p.out, p.norm_g + 3 * 1024, (bf16_t*)(p.ws + OFF_XB), nullptr);
}

__global__ __launch_bounds__(512, 2) void mega_fwd(Params p_) {
    extern __shared__ __attribute__((aligned(16))) unsigned char shm[];
    LAS unsigned char* lds = (LAS unsigned char*)shm;
    volatile LAS unsigned* st = (volatile LAS unsigned*)(lds + LDS_WORK);
    if (threadIdx.x < 4) st[threadIdx.x] = 0u;
    __syncthreads();
    const XcdBarrier xb = xcd_barrier_post((unsigned*)(p_.ws + OFF_BAR), st);
    for (int ph = p_.ph_lo; ph < p_.ph_hi; ++ph) {
        const __attribute__((address_space(4))) Params* pp = (const __attribute__((address_space(4))) Params*)__builtin_amdgcn_kernarg_segment_ptr();
        asm volatile("" : "+s"(pp));
        PR p = *pp;
        if (ph == 0) prep_phase(p, lds);
        else if (ph < PH_B) layerA_phase(p, lds, ph - PH_A0, 0, 0);
        else if (ph < PH_C) layerB_phase(p, lds, ph - PH_B);
        else if (ph < PH_A1) layerC_phase(p, lds, ph - PH_C);
        else layerA_phase(p, lds, ph - PH_A1, 1, 3);
        if (p_.coop && ph + 1 < p_.ph_hi) {
            if (ph == 0) cg::this_grid().sync();
            else xcd_barrier(xb);
        }
    }
}

extern "C" void kernel_launch(void* const* d_in, const int* in_sizes, int n_in, void* d_out, int out_size, void* d_ws, size_t ws_size, hipStream_t stream) {
    static int grid = 0;
    if (grid == 0) {
        int dev = 0, cus = 0, per_cu = 0;
        hipGetDevice(&dev);
        hipDeviceGetAttribute(&cus, hipDeviceAttributeMultiprocessorCount, dev);
        hipFuncSetAttribute((const void*)mega_fwd, hipFuncAttributeMaxDynamicSharedMemorySize, LDS_BYTES);
        hipOccupancyMaxActiveBlocksPerMultiprocessor(&per_cu, (const void*)mega_fwd, 512, LDS_BYTES);
        if (per_cu < 1) per_cu = 1;
        grid = cus * per_cu;
        if (ws_size < WS_NEED) fprintf(stderr, "kernel_launch: workspace too small: %zu < %zu\n", ws_size, (size_t)WS_NEED);
    }
    Params p{};
    const float** f = (const float**)&p;
    for (int i = 0; i < 23; ++i) f[i] = (const float*)d_in[i];
    p.out = (float*)d_out; p.ws = (unsigned char*)d_ws;
    p.ph_lo = 0; p.ph_hi = PH_END; p.coop = 1; p.pad = 0;
    hipMemsetAsync((unsigned char*)d_ws + OFF_BAR, 0, XCD_BAR_BYTES + 256, stream);
    void* args[] = {&p};
    hipError_t e = hipLaunchCooperativeKernel((const void*)mega_fwd, dim3(grid), dim3(512), args, LDS_BYTES, stream);
    if (e != hipSuccess) fprintf(stderr, "cooperative launch failed: %s (grid %d)\n", hipGetErrorString(e), grid);
}
```
